# Optimizing an MI355X kernel written in HIP

```python
import math
import jax
import jax.numpy as jnp
from jax import lax
import numpy as np

D_MODEL = 2048
BATCH = 1
SEQ = 8192
DEPTH = 2

CHUNK = 64
Q_BLOCK = 128
EPS = 1e-6
PLE_DIM = 256
D_FF = 5504
SSD_WIDTH = D_MODEL
SSD_HEAD_DIM = 64
SSD_HEADS = SSD_WIDTH // SSD_HEAD_DIM
SSD_GROUPS = 4
SSD_HPG = SSD_HEADS // SSD_GROUPS
SSD_STATE = 128
SSD_CONV = 4
SSD_CONV_DIM = SSD_WIDTH + 2 * SSD_GROUPS * SSD_STATE
HGRN_WIDTH = D_MODEL
HGRN_KDIM = 128
HGRN_HEADS = HGRN_WIDTH // HGRN_KDIM
HGRN_VDIM = HGRN_WIDTH // HGRN_HEADS
FOX_WIDTH = D_MODEL
FOX_HEAD_DIM = 128
FOX_HEADS = FOX_WIDTH // FOX_HEAD_DIM

N_EVEN = (DEPTH + 1) // 2
N_ODD = DEPTH // 2
AB_SPLITS = (
    SSD_WIDTH,
    SSD_WIDTH + SSD_CONV_DIM,
    SSD_WIDTH + SSD_CONV_DIM + SSD_HEADS,
    SSD_WIDTH + SSD_CONV_DIM + SSD_HEADS + HGRN_WIDTH,
    SSD_WIDTH + SSD_CONV_DIM + SSD_HEADS + 2 * HGRN_WIDTH,
    SSD_WIDTH + SSD_CONV_DIM + SSD_HEADS + 3 * HGRN_WIDTH,
)
AB_IN = SSD_WIDTH + SSD_CONV_DIM + SSD_HEADS + 4 * HGRN_WIDTH
AB_OUT = SSD_WIDTH + HGRN_WIDTH
FOX_IN = 3 * FOX_WIDTH + FOX_HEADS

kernel_name = "hybrid_ssd_hgrn2_fox_macaron_trunk"


def rmsnorm(x, w):
    xf = x.astype(jnp.float32)
    y = xf * lax.rsqrt(jnp.mean(xf * xf, axis=-1, keepdims=True) + EPS)
    return (y * w.astype(jnp.float32)).astype(x.dtype)


def swiglu_half(h, norm_w, w_in, w_out):
    gate, up = jnp.split(rmsnorm(h, norm_w) @ w_in, 2, axis=-1)
    return h + 0.5 * ((jax.nn.silu(gate) * up) @ w_out)


def causal_dwconv(x, w, b):
    k = w.shape[0]
    y = lax.conv_general_dilated(
        x, w[:, None, :].astype(x.dtype), window_strides=(1,), padding=[(k - 1, 0)],
        dimension_numbers=("NWC", "WIO", "NWC"), feature_group_count=x.shape[-1])
    return y + b.astype(x.dtype)


def chunk_state_scan(states, decay):
    def step(carry, inp):
        s_c, a_c = inp
        return carry * a_c + s_c, carry
    init = jnp.zeros_like(states[:, 0])
    _, prev = lax.scan(step, init, (jnp.moveaxis(states, 1, 0), jnp.moveaxis(decay, 1, 0)))
    return jnp.moveaxis(prev, 0, 1)


def ssd_scan(xs, b_in, c_in, dt, a_log, d_skip):
    bsz, t = xs.shape[:2]
    nc = t // CHUNK
    dtype = xs.dtype
    x = xs.reshape(bsz, nc, CHUNK, SSD_GROUPS, SSD_HPG, SSD_HEAD_DIM)
    bm = b_in.reshape(bsz, nc, CHUNK, SSD_GROUPS, SSD_STATE)
    cm = c_in.reshape(bsz, nc, CHUNK, SSD_GROUPS, SSD_STATE)
    dtc = dt.reshape(bsz, nc, CHUNK, SSD_GROUPS, SSD_HPG)
    a = -jnp.exp(a_log.astype(jnp.float32)).reshape(SSD_GROUPS, SSD_HPG)
    cum = jnp.cumsum(dtc * a, axis=2)
    xdt = (x * dtc[..., None]).astype(dtype)
    cum_t = jnp.moveaxis(cum, 2, -1)
    causal = jnp.tril(jnp.ones((CHUNK, CHUNK), dtype=bool))
    decay = jnp.exp(jnp.where(causal, cum_t[..., :, None] - cum_t[..., None, :], -jnp.inf))
    cb = jnp.einsum("bclgn,bcsgn->bcgls", cm, bm).astype(jnp.float32)
    w = (cb[:, :, :, None] * decay).astype(dtype)
    y_diag = jnp.einsum("bcghls,bcsghp->bclghp", w, xdt)
    to_end = jnp.exp(cum[:, :, -1:] - cum)
    states = jnp.einsum("bclgn,bclghp->bcghpn", bm, (xdt * to_end[..., None]).astype(dtype))
    chunk_decay = jnp.exp(cum[:, :, -1]).astype(dtype)[..., None, None]
    prev = chunk_state_scan(states, chunk_decay)
    y_off = jnp.einsum("bclgn,bcghpn->bclghp", cm, prev) * jnp.exp(cum)[..., None].astype(dtype)
    y = y_diag + y_off + x * d_skip.reshape(SSD_GROUPS, SSD_HPG, 1).astype(dtype)
    return y.reshape(bsz, t, SSD_WIDTH)


def hgrn2_scan(q, f_raw, v, lb):
    bsz, t = q.shape[:2]
    nc = t // CHUNK
    dtype = q.dtype
    shp = (bsz, nc, CHUNK, HGRN_HEADS, HGRN_KDIM)
    lbh = lb.astype(jnp.float32).reshape(HGRN_HEADS, HGRN_KDIM)
    f = lbh + (1.0 - lbh) * jax.nn.sigmoid(f_raw.astype(jnp.float32))
    k = (1.0 - f).reshape(shp)
    cum = jnp.cumsum(jnp.log(f).reshape(shp), axis=2)
    qf = jax.nn.silu(q.astype(jnp.float32)).reshape(shp)
    vc = v.reshape(bsz, nc, CHUNK, HGRN_HEADS, HGRN_VDIM)
    mid = cum[:, :, CHUNK // 2 - 1:CHUNK // 2]
    q_rel = (qf * jnp.exp(cum - mid)).astype(dtype)
    k_rel = (k * jnp.exp(mid - cum)).astype(dtype)
    causal = jnp.tril(jnp.ones((CHUNK, CHUNK), dtype=bool))
    att = jnp.where(causal, jnp.einsum("bclhk,bcshk->bchls", q_rel, k_rel), 0)
    o_intra = jnp.einsum("bchls,bcshv->bclhv", att, vc)
    k_end = (k * jnp.exp(cum[:, :, -1:] - cum)).astype(dtype)
    states = jnp.einsum("bclhk,bclhv->bchkv", k_end, vc)
    chunk_decay = jnp.exp(cum[:, :, -1]).astype(dtype)[..., None]
    prev = chunk_state_scan(states, chunk_decay)
    o_inter = jnp.einsum("bclhk,bchkv->bclhv", (qf * jnp.exp(cum)).astype(dtype), prev)
    return (o_intra + o_inter).reshape(bsz, t, HGRN_HEADS, HGRN_VDIM)


def ssd_hgrn_mixer(hn, w_in, conv_w, conv_b, dt_bias, a_log, d_skip, ssd_norm_w, lb, hgrn_norm_w, w_out):
    bsz, t, _ = hn.shape
    z, xbc, dt_raw, q, f_raw, v, g = jnp.split(hn @ w_in, AB_SPLITS, axis=-1)
    xbc = jax.nn.silu(causal_dwconv(xbc, conv_w, conv_b))
    xs, b_in, c_in = jnp.split(xbc, [SSD_WIDTH, SSD_WIDTH + SSD_GROUPS * SSD_STATE], axis=-1)
    dt = jax.nn.softplus(dt_raw.astype(jnp.float32) + dt_bias.astype(jnp.float32))
    y_a = ssd_scan(xs, b_in, c_in, dt, a_log, d_skip) * jax.nn.silu(z)
    grp = SSD_WIDTH // SSD_GROUPS
    y_a = rmsnorm(y_a.reshape(bsz, t, SSD_GROUPS, grp), ssd_norm_w.reshape(SSD_GROUPS, grp)).reshape(bsz, t, SSD_WIDTH)
    y_b = hgrn2_scan(q.reshape(bsz, t, HGRN_HEADS, HGRN_KDIM), f_raw.reshape(bsz, t, HGRN_HEADS, HGRN_KDIM),
                     v.reshape(bsz, t, HGRN_HEADS, HGRN_VDIM), lb)
    y_b = rmsnorm(y_b, hgrn_norm_w.reshape(HGRN_HEADS, HGRN_VDIM)).reshape(bsz, t, HGRN_WIDTH) * jax.nn.silu(g)
    return jnp.concatenate([y_a, y_b], axis=-1) @ w_out


def fox_attention(hn, w_in, b_f, w_out):
    bsz, t, _ = hn.shape
    q, k, v, f_raw = jnp.split(hn @ w_in, [FOX_WIDTH, 2 * FOX_WIDTH, 3 * FOX_WIDTH], axis=-1)
    q = q.reshape(bsz, t, FOX_HEADS, FOX_HEAD_DIM)
    k = k.reshape(bsz, t, FOX_HEADS, FOX_HEAD_DIM)
    v = v.reshape(bsz, t, FOX_HEADS, FOX_HEAD_DIM)
    log_f = jax.nn.log_sigmoid(f_raw.astype(jnp.float32) + b_f.astype(jnp.float32))
    dcum = jnp.swapaxes(jnp.cumsum(log_f, axis=1), 1, 2)
    scale = FOX_HEAD_DIM ** -0.5
    q_idx = jnp.arange(Q_BLOCK)
    outs = []
    for blk in range(t // Q_BLOCK):
        s0 = blk * Q_BLOCK
        s1 = s0 + Q_BLOCK
        logits = jnp.einsum("bqhd,bkhd->bhqk", q[:, s0:s1], k[:, :s1]).astype(jnp.float32) * scale
        logits = logits + dcum[:, :, s0:s1, None] - dcum[:, :, None, :s1]
        mask = (s0 + q_idx)[:, None] >= jnp.arange(s1)[None, :]
        probs = jax.nn.softmax(jnp.where(mask, logits, -jnp.inf), axis=-1).astype(v.dtype)
        outs.append(jnp.einsum("bhqk,bkhd->bqhd", probs, v[:, :s1]))
    o = jnp.concatenate(outs, axis=1).reshape(bsz, t, FOX_WIDTH)
    return o @ w_out


def ple_add(h, p_i, gate_norm_w, w_gate, w_up, post_norm_w):
    emb = rmsnorm(p_i @ w_up, post_norm_w)
    gate = jax.nn.sigmoid(rmsnorm(h, gate_norm_w) @ w_gate)
    return h + emb * gate


def setup_inputs(seed: int = 0) -> dict:
    key = jax.random.key(seed)
    ks = iter(jax.random.split(key, 40))
    f32 = jnp.float32
    D = D_MODEL

    def nrm(shape, scale):
        return jax.random.normal(next(ks), shape, f32) * scale

    def gain(shape):
        return 1.0 + 0.05 * jax.random.normal(next(ks), shape, f32)

    x = nrm((BATCH, SEQ, D), 1.0)
    p = nrm((DEPTH, BATCH, SEQ, PLE_DIM), 1.0)
    ffn1_norm = gain((DEPTH, D))
    ffn1_w_in = nrm((DEPTH, D, 2 * D_FF), D ** -0.5)
    ffn1_w_out = nrm((DEPTH, D_FF, D), D_FF ** -0.5)
    mix_norm = gain((DEPTH, D))
    ab_w_in = nrm((N_EVEN, D, AB_IN), D ** -0.5)
    ssd_conv_w = nrm((N_EVEN, SSD_CONV, SSD_CONV_DIM), SSD_CONV ** -0.5)
    ssd_conv_b = nrm((N_EVEN, SSD_CONV_DIM), 0.02)
    dt0 = jnp.exp(jax.random.uniform(next(ks), (N_EVEN, SSD_HEADS), f32, math.log(1e-3), math.log(1e-1)))
    ssd_dt_bias = dt0 + jnp.log(-jnp.expm1(-dt0))
    ssd_a_log = jnp.log(jax.random.uniform(next(ks), (N_EVEN, SSD_HEADS), f32, 1.0, 16.0))
    ssd_d = gain((N_EVEN, SSD_HEADS))
    ssd_norm = gain((N_EVEN, SSD_WIDTH))
    hgrn_lb_logits = nrm((DEPTH + 1, HGRN_WIDTH), 0.1)
    hgrn_norm = gain((N_EVEN, HGRN_WIDTH))
    ab_w_out = nrm((N_EVEN, AB_OUT, D), AB_OUT ** -0.5)
    fox_w_in = nrm((N_ODD, D, FOX_IN), D ** -0.5)
    fox_b_f = 2.0 + nrm((N_ODD, FOX_HEADS), 0.5)
    fox_w_out = nrm((N_ODD, FOX_WIDTH, D), FOX_WIDTH ** -0.5)
    ffn2_norm = gain((DEPTH, D))
    ffn2_w_in = nrm((DEPTH, D, 2 * D_FF), D ** -0.5)
    ffn2_w_out = nrm((DEPTH, D_FF, D), D_FF ** -0.5)
    ple_gate_norm = gain((DEPTH, D))
    ple_w_gate = nrm((DEPTH, D, D), D ** -0.5)
    ple_w_up = nrm((DEPTH, PLE_DIM, D), PLE_DIM ** -0.5)
    ple_norm = gain((DEPTH, D))
    final_norm = gain((D,))
    return {
        "x": x, "p": p,
        "ffn1_norm": ffn1_norm, "ffn1_w_in": ffn1_w_in, "ffn1_w_out": ffn1_w_out,
        "mix_norm": mix_norm, "ab_w_in": ab_w_in, "ssd_conv_w": ssd_conv_w, "ssd_conv_b": ssd_conv_b,
        "ssd_dt_bias": ssd_dt_bias, "ssd_a_log": ssd_a_log, "ssd_d": ssd_d, "ssd_norm": ssd_norm,
        "hgrn_lb_logits": hgrn_lb_logits, "hgrn_norm": hgrn_norm, "ab_w_out": ab_w_out,
        "fox_w_in": fox_w_in, "fox_b_f": fox_b_f, "fox_w_out": fox_w_out,
        "ffn2_norm": ffn2_norm, "ffn2_w_in": ffn2_w_in, "ffn2_w_out": ffn2_w_out,
        "ple_gate_norm": ple_gate_norm, "ple_w_gate": ple_w_gate, "ple_w_up": ple_w_up, "ple_norm": ple_norm,
        "final_norm": final_norm,
    }


def reference(x, p, ffn1_norm, ffn1_w_in, ffn1_w_out, mix_norm, ab_w_in, ssd_conv_w, ssd_conv_b,
              ssd_dt_bias, ssd_a_log, ssd_d, ssd_norm, hgrn_lb_logits, hgrn_norm, ab_w_out,
              fox_w_in, fox_b_f, fox_w_out, ffn2_norm, ffn2_w_in, ffn2_w_out,
              ple_gate_norm, ple_w_gate, ple_w_up, ple_norm, final_norm):
    lb_all = jnp.cumsum(jax.nn.softmax(hgrn_lb_logits.astype(jnp.float32), axis=0), axis=0)
    h = x
    for i in range(DEPTH):
        h = swiglu_half(h, ffn1_norm[i], ffn1_w_in[i], ffn1_w_out[i])
        hn = rmsnorm(h, mix_norm[i])
        j = i // 2
        if i % 2 == 0:
            h = h + ssd_hgrn_mixer(hn, ab_w_in[j], ssd_conv_w[j], ssd_conv_b[j], ssd_dt_bias[j], ssd_a_log[j],
                                   ssd_d[j], ssd_norm[j], lb_all[i], hgrn_norm[j], ab_w_out[j])
        else:
            h = h + fox_attention(hn, fox_w_in[j], fox_b_f[j], fox_w_out[j])
        h = swiglu_half(h, ffn2_norm[i], ffn2_w_in[i], ffn2_w_out[i])
        h = ple_add(h, p[i], ple_gate_norm[i], ple_w_gate[i], ple_w_up[i], ple_norm[i])
    return rmsnorm(h, final_norm)
```

```cpp
#include <hip/hip_runtime.h>
#include <hip/hip_cooperative_groups.h>
#include <cstdio>
namespace cg = cooperative_groups;
#ifndef ONE_LAUNCH
#define ONE_LAUNCH 0
#endif
namespace pg8 {
#define PG8_LAS __attribute__((address_space(3)))
typedef unsigned short bf16_t;
typedef short bf16x8 __attribute__((ext_vector_type(8)));
typedef float f32x4 __attribute__((ext_vector_type(4)));
typedef unsigned u32x4 __attribute__((ext_vector_type(4)));
constexpr int BM = 256, BK = 64, HALF = 128, HTB = HALF * BK * 2  , STAGE_BYTES = 8 * HTB, NXCD = 8, WGM = 8;

__host__ __device__ __forceinline__ int lds_byte(int r, int c) { const int st = (r >> 4) * 2 + (c >> 5), rr = r & 15, cc = c & 31, ob = rr * 64 + cc * 2; return st * 1024 + (ob ^ (((ob >> 9) & 1) << 5)); }
__host__ __device__ __forceinline__ void stage_rc(int b, int& R, int& C) { const int st = b / 1024, sb = b % 1024, swz = sb ^ (((sb >> 9) & 1) << 5); R = (st >> 1) * 16 + swz / 64; C = (st & 1) * 32 + (swz % 64) / 2; }
__host__ __device__ __forceinline__ int perm32(int rho) { const int n = rho >> 4, i = rho & 15; return 8 * (i >> 2) + 4 * n + (i & 3); }

struct Unit { int pm, pn; };
struct Gemm { const bf16_t* A; const bf16_t* Bt; int M, N, K; };

struct StaticOrder {
    int nM, nN, nwg, G, c;
    __host__ __device__ void init(int M, int N, int G_, int c_) { nM = M / BM; nN = N / BM; nwg = nM * nN; G = G_; c = c_; }
    __host__ __device__ bool next(int i, Unit& u) const {
        const long L = (long)i * G + c; if (L >= nwg) return false;
        int wgid = (int)L; { const int q = nwg / NXCD, r = nwg % NXCD, xcd = wgid % NXCD, off = wgid / NXCD; wgid = (xcd < r ? xcd * (q + 1) : r * (q + 1) + (xcd - r) * q) + off; }
        const int nig = WGM * nN, gid = wgid / nig, fm = gid * WGM, gsz = (nM - fm) < WGM ? (nM - fm) : WGM;
        u.pm = fm + ((wgid % nig) % gsz); u.pn = (wgid % nig) / gsz; return true;
    }
    __device__ __forceinline__ void a_ready(const Unit&) const {}
    __device__ __forceinline__ void done(const Unit&) const {}
};
typedef unsigned u32x2 __attribute__((ext_vector_type(2)));
typedef float f32x2 __attribute__((ext_vector_type(2)));
__device__ __forceinline__ unsigned cvt_pk_bf16(float lo, float hi) { unsigned r; asm volatile("v_cvt_pk_bf16_f32 %0, %1, %2" : "=v"(r) : "v"(lo), "v"(hi)); return r; }
__device__ __forceinline__ bf16_t f2bf(float x) { return (bf16_t)(cvt_pk_bf16(x, 0.f) & 0xffffu); }
__device__ __forceinline__ float bf2f(bf16_t b) { return __uint_as_float(((unsigned)b) << 16); }
__device__ __forceinline__ float bflo(unsigned w) { return __uint_as_float(w << 16); }
__device__ __forceinline__ float bfhi(unsigned w) { return __uint_as_float(w & 0xffff0000u); }
__device__ __forceinline__ float sigmoidf_(float x) { return __builtin_amdgcn_rcpf(1.0f + __expf(-x)); }
__device__ __forceinline__ float siluf_(float x) { return x * sigmoidf_(x); }
__device__ __forceinline__ float softplusf_(float x) { return fmaxf(x, 0.f) + log1pf(__expf(-fabsf(x))); }

struct EpiSwiGLU {
    static constexpr bool PERM = true, AFTER_DRAIN = false;
    bf16_t* O; int ldc;
    __device__ __forceinline__ void operator()(const f32x4 (&acc)[2][2][4][2], const Unit& u, int wr, int wc, int fr, int fq) const {
        const int row0 = u.pm * BM + wr * 64 + fr, col0 = u.pn * 128 + wc * 32 + 8 * fq;
#pragma unroll
        for (int ai = 0; ai < 2; ++ai)
#pragma unroll
            for (int m = 0; m < 4; ++m) {
                bf16_t* rowp = O + (size_t)(row0 + ai * HALF + m * 16) * ldc + col0;
                f32x4 v0, v1;
#pragma unroll
                for (int j = 0; j < 4; ++j) { v0[j] = siluf_(acc[ai][0][m][0][j]) * acc[ai][1][m][0][j]; v1[j] = siluf_(acc[ai][0][m][1][j]) * acc[ai][1][m][1][j]; }
                u32x4 w; w.x = cvt_pk_bf16(v0[0], v0[1]); w.y = cvt_pk_bf16(v0[2], v0[3]); w.z = cvt_pk_bf16(v1[0], v1[1]); w.w = cvt_pk_bf16(v1[2], v1[3]);
                *(u32x4*)rowp = w;
            }
    }
};
struct EpiResid {
    static constexpr bool PERM = false, AFTER_DRAIN = false;
    const float* base; float* out; int ldc; float alpha;
    __device__ __forceinline__ void operator()(const f32x4 (&acc)[2][2][4][2], const Unit& u, int wr, int wc, int fr, int fq) const {
        const int row0 = u.pm * BM + wr * 64 + fr, col0 = u.pn * BM + wc * 32 + 4 * fq;
#pragma unroll
        for (int ai = 0; ai < 2; ++ai)
#pragma unroll
            for (int m = 0; m < 4; ++m) { const size_t off = (size_t)(row0 + ai * HALF + m * 16) * ldc + col0;
#pragma unroll
                for (int bj = 0; bj < 2; ++bj)
#pragma unroll
                    for (int n = 0; n < 2; ++n) { const f32x4 b = *(const f32x4*)(base + off + bj * HALF + n * 16); *(f32x4*)(out + off + bj * HALF + n * 16) = b + alpha * acc[ai][bj][m][n]; }
                asm volatile("" ::: "memory"); }
    }
};
struct EpiProj {
    static constexpr bool PERM = true, AFTER_DRAIN = false;
    bf16_t* O; int ldc; int n_bf; float* aux;
    __device__ __forceinline__ void operator()(const f32x4 (&acc)[2][2][4][2], const Unit& u, int wr, int wc, int fr, int fq) const {
        const int row0 = u.pm * BM + wr * 64 + fr;
        if (u.pn < n_bf) {
            const int col0 = u.pn * BM + wc * 32 + 8 * fq;
#pragma unroll
            for (int ai = 0; ai < 2; ++ai)
#pragma unroll
                for (int m = 0; m < 4; ++m) { bf16_t* rowp = O + (size_t)(row0 + ai * HALF + m * 16) * ldc + col0;
#pragma unroll
                    for (int bj = 0; bj < 2; ++bj) { const f32x4 v0 = acc[ai][bj][m][0], v1 = acc[ai][bj][m][1];
                        u32x4 w; w.x = cvt_pk_bf16(v0[0], v0[1]); w.y = cvt_pk_bf16(v0[2], v0[3]); w.z = cvt_pk_bf16(v1[0], v1[1]); w.w = cvt_pk_bf16(v1[2], v1[3]);
                        *(u32x4*)(rowp + bj * HALF) = w; } }
        } else {
            const int col0 = wc * 32 + 8 * fq;
#pragma unroll
            for (int ai = 0; ai < 2; ++ai)
#pragma unroll
                for (int m = 0; m < 4; ++m) { float* rowp = aux + (size_t)(row0 + ai * HALF + m * 16) * 256 + col0;
#pragma unroll
                    for (int bj = 0; bj < 2; ++bj)
#pragma unroll
                        for (int n = 0; n < 2; ++n) *(f32x4*)(rowp + bj * HALF + 4 * n) = acc[ai][bj][m][n]; }
        }
    }
};
struct EpiStoreF32 {
    static constexpr bool PERM = false, AFTER_DRAIN = false;
    float* C; int ldc;
    __device__ __forceinline__ void operator()(const f32x4 (&acc)[2][2][4][2], const Unit& u, int wr, int wc, int fr, int fq) const {
        const int row0 = u.pm * BM + wr * 64 + fr, col0 = u.pn * BM + wc * 32 + 4 * fq;
#pragma unroll
        for (int ai = 0; ai < 2; ++ai)
#pragma unroll
            for (int m = 0; m < 4; ++m) { float* rowp = C + (size_t)(row0 + ai * HALF + m * 16) * ldc + col0;
#pragma unroll
                for (int bj = 0; bj < 2; ++bj)
#pragma unroll
                    for (int n = 0; n < 2; ++n) *(f32x4*)(rowp + bj * HALF + n * 16) = acc[ai][bj][m][n]; }
    }
};
struct EpiPle {
    static constexpr bool PERM = false, AFTER_DRAIN = false;
    const float* E; const float* rstdE; const float* wpost; float* h; int ldc;
    __device__ __forceinline__ void operator()(const f32x4 (&acc)[2][2][4][2], const Unit& u, int wr, int wc, int fr, int fq) const {
        const int row0 = u.pm * BM + wr * 64 + fr, col0 = u.pn * BM + wc * 32 + 4 * fq;
#pragma unroll
        for (int ai = 0; ai < 2; ++ai)
#pragma unroll
            for (int m = 0; m < 4; ++m) { const int row = row0 + ai * HALF + m * 16; const size_t off = (size_t)row * ldc + col0; const float rs = rstdE[row];
#pragma unroll
                for (int bj = 0; bj < 2; ++bj)
#pragma unroll
                    for (int n = 0; n < 2; ++n) { const int o2 = bj * HALF + n * 16; const f32x4 e = *(const f32x4*)(E + off + o2), w = *(const f32x4*)(wpost + col0 + o2), b = *(const f32x4*)(h + off + o2);
                        f32x4 r;
#pragma unroll
                        for (int j = 0; j < 4; ++j) r[j] = b[j] + e[j] * rs * w[j] * sigmoidf_(acc[ai][bj][m][n][j]);
                        *(f32x4*)(h + off + o2) = r; }
                asm volatile("" ::: "memory"); }
    }
};
template <class Epi, class Sched, bool STAMP = false>
__device__ __forceinline__ void gemm_phase(PG8_LAS unsigned char* lds, const Gemm g, const Sched& S, const Epi& E, unsigned long long* stamps) {
    int tid = threadIdx.x; asm volatile("" : "+v"(tid)); const int wid = __builtin_amdgcn_readfirstlane(tid >> 6), lane = tid & 63, wr = wid >> 2, wc = wid & 3, fr = lane & 15, fq = lane >> 4;
    const int K = g.K, nt = K / BK;
    int ts_lo = 0, ts_hi = 0, nts = 0; const unsigned long long rt_entry = STAMP ? (unsigned long long)wall_clock64() : 0ull;
#define PG8_STAMP() do { if (STAMP && wid == 0 && nts < 64) { const unsigned long long _c = (unsigned long long)clock64(); \
        ts_lo = (lane == nts) ? (int)(unsigned)_c : ts_lo; ts_hi = (lane == nts) ? (int)(unsigned)(_c >> 32) : ts_hi; ++nts; } } while (0)
    PG8_STAMP();
    unsigned voffA[2], voffB[2];
#pragma unroll
    for (int i = 0; i < 2; ++i) { int R, C; stage_rc(tid * 16 + i * 8192, R, C); const int Rb = Epi::PERM ? ((R & ~31) + perm32(R & 31)) : R;
        voffA[i] = (unsigned)(R * K + C) * 2u; voffB[i] = (unsigned)(Rb * K + C) * 2u; }
    const size_t kstep = (size_t)(BK * 2);
    const size_t hstep = (size_t)HALF * K * 2;
    const size_t tstep = 2 * hstep;
    const unsigned ldsw = (unsigned)wid * 1024u;
    const int aoff = lds_byte(wr * 64 + fr, fq * 8), boff = lds_byte(wc * 32 + fr, fq * 8);
#define PG8_SA(b, h) (((b) * 2 + (h)) * HTB)
#define PG8_SB(b, h) ((4 + (b) * 2 + (h)) * HTB)
#define PG8_STAGE(bufoff, gbase, voff) do { _Pragma("unroll") for (int _i = 0; _i < 2; ++_i) \
        __builtin_amdgcn_global_load_lds((const unsigned*)((const char*)(gbase) + (voff)[_i]), (PG8_LAS unsigned*)(lds + (bufoff) + ldsw + _i * 8192), 16, 0, 0); } while (0)
#define PG8_LDA(dst, b, h) do { _Pragma("unroll") for (int m = 0; m < 4; ++m) _Pragma("unroll") for (int k = 0; k < 2; ++k) dst[m][k] = *(const PG8_LAS bf16x8*)(lds + PG8_SA(b, h) + aoff + m * 2048 + k * 1024); } while (0)
#define PG8_LDB(dst, b, h) do { _Pragma("unroll") for (int n = 0; n < 2; ++n) _Pragma("unroll") for (int k = 0; k < 2; ++k) dst[n][k] = *(const PG8_LAS bf16x8*)(lds + PG8_SB(b, h) + boff + n * 2048 + k * 1024); } while (0)
#define PG8_MMA(ai, bj, At, Bt) do { __builtin_amdgcn_s_setprio(1); _Pragma("unroll") for (int m = 0; m < 4; ++m) _Pragma("unroll") for (int n = 0; n < 2; ++n) _Pragma("unroll") for (int k = 0; k < 2; ++k) \
        acc[ai][bj][m][n] = __builtin_amdgcn_mfma_f32_16x16x32_bf16(Bt[n][k], At[m][k], acc[ai][bj][m][n], 0, 0, 0); __builtin_amdgcn_s_setprio(0); } while (0)
#define PG8_WAIT_V(n) asm volatile("s_waitcnt vmcnt(" #n ")" ::: "memory")
#define PG8_WAIT_L(n) asm volatile("s_waitcnt lgkmcnt(" #n ")" ::: "memory")
#define PG8_BAR __builtin_amdgcn_s_barrier()
#define PG8_SCHED __builtin_amdgcn_sched_barrier(0)
    Unit cur, nxt; int ui = 0;
    if (!S.next(0, cur)) return;
    f32x4 acc[2][2][4][2];
#pragma unroll
    for (int a = 0; a < 2; ++a)
#pragma unroll
        for (int b = 0; b < 2; ++b)
#pragma unroll
            for (int m = 0; m < 4; ++m)
#pragma unroll
                for (int n = 0; n < 2; ++n) acc[a][b][m][n] = (f32x4){0.f, 0.f, 0.f, 0.f};
    bf16x8 At[4][2], B0[2][2], B1[2][2];
    const char* cA = (const char*)g.A + (size_t)cur.pm * tstep; const char* cB = (const char*)g.Bt + (size_t)cur.pn * tstep;
    S.a_ready(cur);
    PG8_STAGE(PG8_SB(0, 0), cB, voffB); PG8_STAGE(PG8_SA(0, 0), cA, voffA); PG8_STAGE(PG8_SB(0, 1), cB + hstep, voffB); PG8_STAGE(PG8_SA(0, 1), cA + hstep, voffA);
    if (wr == 1) PG8_BAR;
    PG8_WAIT_V(4); PG8_BAR;
    PG8_STAGE(PG8_SB(1, 0), cB + kstep, voffB); PG8_STAGE(PG8_SA(1, 0), cA + kstep, voffA); PG8_STAGE(PG8_SB(1, 1), cB + hstep + kstep, voffB);
    PG8_WAIT_V(6); PG8_BAR;
    PG8_STAMP();
    for (;;) {
        const bool has_next = S.next(ui + 1, nxt);
        const char* nA = has_next ? (const char*)g.A + (size_t)nxt.pm * tstep : cA; const char* nB = has_next ? (const char*)g.Bt + (size_t)nxt.pn * tstep : cB;
        for (int t = 0; t < nt; t += 2) {
            const bool last = (t == nt - 2);
            const char* a1 = cA + (size_t)(t + 1) * kstep;
            const char* a2 = last ? nA : cA + (size_t)(t + 2) * kstep; const char* b2 = last ? nB : cB + (size_t)(t + 2) * kstep;
            const char* a3 = a2 + kstep; const char* b3 = b2 + kstep;
            if (last && has_next) S.a_ready(nxt);
            PG8_LDB(B0, 0, 0); PG8_SCHED; PG8_LDA(At, 0, 0); PG8_STAGE(PG8_SA(1, 1), a1 + hstep, voffA);
            PG8_WAIT_L(8); PG8_BAR; PG8_WAIT_L(0); PG8_MMA(0, 0, At, B0); PG8_BAR; PG8_SCHED;
            PG8_LDB(B1, 0, 1); PG8_STAGE(PG8_SB(0, 0), b2, voffB);
            PG8_BAR; PG8_WAIT_L(0); PG8_MMA(0, 1, At, B1); PG8_BAR;
            PG8_LDA(At, 0, 1); PG8_STAGE(PG8_SA(0, 0), a2, voffA);
            PG8_BAR; PG8_WAIT_L(0); PG8_MMA(1, 0, At, B0); PG8_BAR; PG8_SCHED;
            PG8_STAGE(PG8_SB(0, 1), b2 + hstep, voffB);
            PG8_WAIT_V(6); PG8_BAR; PG8_MMA(1, 1, At, B1); PG8_BAR;
            PG8_LDB(B0, 1, 0); PG8_SCHED; PG8_LDA(At, 1, 0); PG8_STAGE(PG8_SA(0, 1), a2 + hstep, voffA);
            PG8_WAIT_L(8); PG8_BAR; PG8_WAIT_L(0); PG8_MMA(0, 0, At, B0); PG8_BAR; PG8_SCHED;
            PG8_LDB(B1, 1, 1); PG8_STAGE(PG8_SB(1, 0), b3, voffB);
            PG8_BAR; PG8_WAIT_L(0); PG8_MMA(0, 1, At, B1); PG8_BAR;
            PG8_LDA(At, 1, 1); PG8_STAGE(PG8_SA(1, 0), a3, voffA);
            PG8_BAR; PG8_WAIT_L(0); PG8_MMA(1, 0, At, B0); PG8_BAR; PG8_SCHED;
            PG8_STAGE(PG8_SB(1, 1), b3 + hstep, voffB);
            PG8_WAIT_V(6); PG8_BAR; PG8_MMA(1, 1, At, B1); PG8_BAR;
        }
        PG8_STAMP();
        if constexpr (!Epi::AFTER_DRAIN) { E(acc, cur, wr, wc, fr, fq); S.done(cur); }
        PG8_STAMP();
        if (!has_next) break;
#pragma unroll
        for (int a = 0; a < 2; ++a)
#pragma unroll
            for (int b = 0; b < 2; ++b)
#pragma unroll
                for (int m = 0; m < 4; ++m)
#pragma unroll
                    for (int n = 0; n < 2; ++n) acc[a][b][m][n] = (f32x4){0.f, 0.f, 0.f, 0.f};
        cur = nxt; cA = nA; cB = nB; ++ui;
    }
    PG8_WAIT_V(0);
    if (wr == 0) PG8_BAR;
    PG8_BAR;
    if constexpr (Epi::AFTER_DRAIN) { E.fused(acc, cur, wr, wc, fr, fq, lds, wid, lane); S.done(cur); }
    PG8_STAMP();
    if (STAMP && wid == 0) { stamps[lane] = lane < nts ? (((unsigned long long)(unsigned)ts_hi << 32) | (unsigned)ts_lo) : 0ull;
        if (lane == 62) stamps[62] = rt_entry; if (lane == 63) stamps[63] = (unsigned long long)wall_clock64(); }
#undef PG8_STAMP
#undef PG8_SA
#undef PG8_SB
#undef PG8_STAGE
#undef PG8_LDA
#undef PG8_LDB
#undef PG8_MMA
#undef PG8_WAIT_V
#undef PG8_WAIT_L
#undef PG8_BAR
#undef PG8_SCHED
}
}
using namespace pg8;

constexpr int T = 8192, D = 2048, DFF = 5504, NFF = 2 * DFF;
constexpr int NAB = 13568, NAB_BF = 13312, NFOX = 6400, NFOX_BF = 6144;
constexpr int PZ = 0, PXBC = 2048, PQ = 5120, PF = 7168, PV_ = 9216, PG = 11264;
constexpr float EPS = 1e-6f;
constexpr int NTHR = 512;
constexpr int LDS_BYTES = 131072;
constexpr size_t OFF_H = 0, SZ_H = (size_t)T * D * 4;
constexpr size_t OFF_XN = OFF_H + SZ_H, SZ_XN = (size_t)T * D * 2;
constexpr size_t OFF_WB0 = OFF_XN + SZ_XN, SZ_WB0 = (size_t)NAB * D * 2;
constexpr size_t OFF_WB1 = OFF_WB0 + SZ_WB0, SZ_WB1 = (size_t)D * DFF * 2;
constexpr size_t OFF_BIG = OFF_WB1 + SZ_WB1;
constexpr size_t OFF_ACT = OFF_BIG;
constexpr size_t OFF_PROJ = OFF_BIG, SZ_PROJ = (size_t)T * NAB_BF * 2;
constexpr size_t OFF_AUX = OFF_PROJ + SZ_PROJ, SZ_AUX = (size_t)T * 256 * 4;
constexpr size_t OFF_XC = OFF_AUX + SZ_AUX, SZ_XC = (size_t)T * 3072 * 2;
constexpr size_t OFF_STS = OFF_XC + SZ_XC, SZ_STS = (size_t)128 * 32 * 64 * 128 * 4;
constexpr size_t OFF_STH = OFF_STS + SZ_STS, SZ_STH = (size_t)128 * 16 * 128 * 128 * 4;
constexpr size_t OFF_Y = OFF_STH + SZ_STH, SZ_Y = (size_t)T * 4096 * 2;
constexpr size_t OFF_CDS = OFF_Y + SZ_Y, SZ_CDS = 128 * 32 * 4;
constexpr size_t OFF_CDH = OFF_CDS + SZ_CDS, SZ_CDH = 128 * 16 * 128 * 4;
constexpr size_t WS_END = OFF_CDH + SZ_CDH;
constexpr size_t OFF_QKV = OFF_BIG, SZ_QKV = (size_t)T * NFOX_BF * 2;
constexpr size_t OFF_FAUX = OFF_QKV + SZ_QKV;
constexpr size_t OFF_DCUM = OFF_FAUX + SZ_AUX, SZ_DCUM = 16 * T * 4;
constexpr size_t OFF_O = OFF_DCUM + SZ_DCUM;
constexpr size_t OFF_PB = OFF_BIG, SZ_PB = (size_t)T * 256 * 2;
constexpr size_t OFF_E = OFF_PB + SZ_PB, SZ_E = (size_t)T * D * 4;
constexpr size_t OFF_RSTD = OFF_E + SZ_E;

struct Params { const float* in[27]; float* out; unsigned char* ws; int ph_lo, ph_hi; };

__device__ __forceinline__ float wave_sum(float v) {
#pragma unroll
    for (int o = 32; o >= 1; o >>= 1) v += __shfl_xor(v, o);
    return v;
}
template <bool F32OUT>
__device__ __forceinline__ void rmsnorm_phase(const float* X, const float* w, bf16_t* ob, float* of) {
    int tq = threadIdx.x; asm volatile("" : "+v"(tq)); const int lane = tq & 63, gw = blockIdx.x * 8 + (tq >> 6), nw = gridDim.x * 8;
    for (int row = gw; row < T; row += nw) {
        const f32x4* xr = (const f32x4*)(X + (size_t)row * D);
        f32x4 v[8]; float ss = 0.f;
#pragma unroll
        for (int i = 0; i < 8; ++i) { v[i] = xr[lane + 64 * i]; ss += v[i][0] * v[i][0] + v[i][1] * v[i][1] + v[i][2] * v[i][2] + v[i][3] * v[i][3]; }
        ss = wave_sum(ss);
        const float rstd = rsqrtf(ss * (1.0f / D) + EPS);
#pragma unroll
        for (int i = 0; i < 8; ++i) { const f32x4 wv = ((const f32x4*)w)[lane + 64 * i]; const f32x4 y = v[i] * rstd * wv;
            if (F32OUT) ((f32x4*)(of + (size_t)row * D))[lane + 64 * i] = y;
            else { u32x2 p; p.x = cvt_pk_bf16(y[0], y[1]); p.y = cvt_pk_bf16(y[2], y[3]); ((u32x2*)(ob + (size_t)row * D))[lane + 64 * i] = p; } }
    }
}
__device__ __forceinline__ void rowrstd_phase(const float* X, float* rs) {
    int tq = threadIdx.x; asm volatile("" : "+v"(tq)); const int lane = tq & 63, gw = blockIdx.x * 8 + (tq >> 6), nw = gridDim.x * 8;
    for (int row = gw; row < T; row += nw) {
        const f32x4* xr = (const f32x4*)(X + (size_t)row * D); float ss = 0.f;
#pragma unroll
        for (int i = 0; i < 8; ++i) { const f32x4 v = xr[lane + 64 * i]; ss += v[0] * v[0] + v[1] * v[1] + v[2] * v[2] + v[3] * v[3]; }
        ss = wave_sum(ss);
        if (lane == 0) rs[row] = rsqrtf(ss * (1.0f / D) + EPS);
    }
}
__device__ __forceinline__ int src_col(int mode, int n, int Nsrc) {
    if (mode == 1) { const int pn = n >> 8, r = n & 255; return (r >> 7) * DFF + pn * 128 + (r & 127); }
    if (mode == 2) { if (n < 5120) return n; if (n < 13312) return n + 32; if (n < 13344) return n - 13312 + 5120; return -1; }
    return n < Nsrc ? n : -1;
}
__device__ __forceinline__ void convert_w(const float* W, int K, int Nsrc, bf16_t* Bt, int Ndst, int mode, unsigned char* lds) {
    float* tile = (float*)lds;
    int t = threadIdx.x; asm volatile("" : "+v"(t)); const int nkt = K >> 6, ntiles = (Ndst >> 6) * nkt;
    for (int tl = blockIdx.x; tl < ntiles; tl += gridDim.x) {
        const int n0 = (tl / nkt) << 6, k0 = (tl % nkt) << 6;
        { const int nn = t & 63, kr = t >> 6; const int sc = src_col(mode, n0 + nn, Nsrc);
#pragma unroll
          for (int i = 0; i < 8; ++i) { const int k = kr + 8 * i; tile[k * 65 + nn] = sc >= 0 ? W[(size_t)(k0 + k) * Nsrc + sc] : 0.f; } }
        __syncthreads();
        { const int nn = t >> 3, kc = (t & 7) * 8; float v[8];
#pragma unroll
          for (int e = 0; e < 8; ++e) v[e] = tile[(kc + e) * 65 + nn];
          u32x4 w; w.x = cvt_pk_bf16(v[0], v[1]); w.y = cvt_pk_bf16(v[2], v[3]); w.z = cvt_pk_bf16(v[4], v[5]); w.w = cvt_pk_bf16(v[6], v[7]);
          *(u32x4*)(Bt + (size_t)(n0 + nn) * K + k0 + kc) = w; }
        __syncthreads();
    }
}
__device__ __forceinline__ void convert_flat(const float* src, bf16_t* dst, int n) {
    int tq = threadIdx.x; asm volatile("" : "+v"(tq)); const int gt = blockIdx.x * NTHR + tq, ng = gridDim.x * NTHR;
    for (int i = gt; i < n / 4; i += ng) { const f32x4 v = ((const f32x4*)src)[i]; u32x2 p; p.x = cvt_pk_bf16(v[0], v[1]); p.y = cvt_pk_bf16(v[2], v[3]); ((u32x2*)dst)[i] = p; }
}
__device__ __forceinline__ void conv_phase(const bf16_t* PROJ, const float* cw, const float* cb, bf16_t* XC) {
    int tq = threadIdx.x; asm volatile("" : "+v"(tq)); const int gt = blockIdx.x * NTHR + tq, ng = gridDim.x * NTHR;
    for (int i = gt; i < T * 384; i += ng) {
        const int t = i / 384, c8 = (i % 384) * 8;
        float a[8];
#pragma unroll
        for (int e = 0; e < 8; ++e) a[e] = cb[c8 + e];
#pragma unroll
        for (int k = 0; k < 4; ++k) { const int tt = t - 3 + k;
            if (tt >= 0) { const u32x4 xv = *(const u32x4*)(PROJ + (size_t)tt * NAB_BF + PXBC + c8); const float* wk = cw + k * 3072 + c8;
                a[0] += bflo(xv.x) * wk[0]; a[1] += bfhi(xv.x) * wk[1]; a[2] += bflo(xv.y) * wk[2]; a[3] += bfhi(xv.y) * wk[3];
                a[4] += bflo(xv.z) * wk[4]; a[5] += bfhi(xv.z) * wk[5]; a[6] += bflo(xv.w) * wk[6]; a[7] += bfhi(xv.w) * wk[7]; } }
        u32x4 w; w.x = cvt_pk_bf16(siluf_(a[0]), siluf_(a[1])); w.y = cvt_pk_bf16(siluf_(a[2]), siluf_(a[3])); w.z = cvt_pk_bf16(siluf_(a[4]), siluf_(a[5])); w.w = cvt_pk_bf16(siluf_(a[6]), siluf_(a[7]));
        *(u32x4*)(XC + (size_t)t * 3072 + c8) = w;
    }
}

__device__ __forceinline__ bf16x8 frag(const bf16_t* X, int ld, int row0, int k0, int lane) { return *(const bf16x8*)(X + (row0 + (lane & 15)) * ld + k0 + (lane >> 4) * 8); }
#define MMA_T(acc, Aop, Bop) acc = __builtin_amdgcn_mfma_f32_16x16x32_bf16(Bop, Aop, acc, 0, 0, 0)

__device__ __forceinline__ void ssd_dtcum(const float* AUX, const float* dt_bias, const float* a_log, int c, int h, float* dts, float* cums) {
    int tq = threadIdx.x; asm volatile("" : "+v"(tq)); if (tq < 64) { const int l = tq;
        const float dt = softplusf_(AUX[(size_t)(c * 64 + l) * 256 + h] + dt_bias[h]);
        float s = dt * (-__expf(a_log[h]));
#pragma unroll
        for (int o = 1; o < 64; o <<= 1) { const float u = __shfl_up(s, o); if (l >= o) s += u; }
        dts[l] = dt; cums[l] = s; }
}

__device__ __forceinline__ void ssd_states(const bf16_t* XC, const float* AUX, const float* dt_bias, const float* a_log, float* STS, float* CDS, unsigned char* lds) {
    bf16_t* XWt = (bf16_t*)lds;
    bf16_t* Bt = (bf16_t*)(lds + 9216);
    float* dts = (float*)(lds + 9216 + 18432);
    float* cums = dts + 64;
    int t = threadIdx.x; asm volatile("" : "+v"(t)); const int lane = t & 63, w = t >> 6;
    for (int it = blockIdx.x; it < 128 * 32; it += gridDim.x) {
        const int c = it >> 5, h = it & 31, g = h >> 3;
        ssd_dtcum(AUX, dt_bias, a_log, c, h, dts, cums);
        __syncthreads();
        { const int l = t >> 3, p8 = (t & 7) * 8; const float sc = dts[l] * __expf(cums[63] - cums[l]);
          const u32x4 xv = *(const u32x4*)(XC + (size_t)(c * 64 + l) * 3072 + h * 64 + p8);
          const unsigned xs[4] = {xv.x, xv.y, xv.z, xv.w};
#pragma unroll
          for (int e = 0; e < 4; ++e) { XWt[(p8 + 2 * e) * 72 + l] = f2bf(bflo(xs[e]) * sc); XWt[(p8 + 2 * e + 1) * 72 + l] = f2bf(bfhi(xs[e]) * sc); } }
#pragma unroll
        for (int i = 0; i < 2; ++i) { const int l = (t >> 4) + 32 * i, n8 = (t & 15) * 8;
          const u32x4 bv = *(const u32x4*)(XC + (size_t)(c * 64 + l) * 3072 + 2048 + g * 128 + n8);
          const unsigned bs[4] = {bv.x, bv.y, bv.z, bv.w};
#pragma unroll
          for (int e = 0; e < 4; ++e) { Bt[(n8 + 2 * e) * 72 + l] = (bf16_t)(bs[e] & 0xffffu); Bt[(n8 + 2 * e + 1) * 72 + l] = (bf16_t)(bs[e] >> 16); } }
        if (t == 0) CDS[c * 32 + h] = __expf(cums[63]);
        __syncthreads();
        { const int p0 = (w & 3) * 16; const bf16x8 a0 = frag(XWt, 72, p0, 0, lane), a1 = frag(XWt, 72, p0, 32, lane);
#pragma unroll
          for (int i = 0; i < 4; ++i) { const int n0 = ((w >> 2) * 4 + i) * 16; f32x4 acc = {0.f, 0.f, 0.f, 0.f};
            MMA_T(acc, a0, frag(Bt, 72, n0, 0, lane)); MMA_T(acc, a1, frag(Bt, 72, n0, 32, lane));
            *(f32x4*)(STS + ((size_t)(c * 32 + h) * 64 + p0 + (lane & 15)) * 128 + n0 + 4 * (lane >> 4)) = acc; } }
        __syncthreads();
    }
}
__device__ __forceinline__ float hgrn_lb(const float* lg, int j) {
    const float a = lg[j], b = lg[2048 + j], c = lg[4096 + j], m = fmaxf(a, fmaxf(b, c));
    const float ea = __expf(a - m), eb = __expf(b - m), ec = __expf(c - m); return ea / (ea + eb + ec);
}
__device__ __forceinline__ void hgrn_states(const bf16_t* PROJ, const float* lbl, float* STH, float* CDH, unsigned char* lds) {
    bf16_t* KEt = (bf16_t*)lds;
    bf16_t* Vt = (bf16_t*)(lds + 18432);
    float* part = (float*)(lds + 36864);
    int t = threadIdx.x; asm volatile("" : "+v"(t)); const int lane = t & 63, w = t >> 6, k = t & 127, lq = t >> 7;
    for (int it = blockIdx.x; it < 128 * 16; it += gridDim.x) {
        const int c = it >> 4, h = it & 15;
        const float lb = hgrn_lb(lbl, h * 128 + k);
        float lf[16], kk[16], s = 0.f;
#pragma unroll
        for (int i = 0; i < 16; ++i) { const int l = lq * 16 + i; const float fr = bf2f(PROJ[(size_t)(c * 64 + l) * NAB_BF + PF + h * 128 + k]);
            const float f = lb + (1.0f - lb) * sigmoidf_(fr); kk[i] = 1.0f - f; lf[i] = __logf(f); s += lf[i]; }
        part[lq * 128 + k] = s;
#pragma unroll
        for (int i = 0; i < 2; ++i) { const int l = (t >> 4) + 32 * i, v8 = (t & 15) * 8;
          const u32x4 vv = *(const u32x4*)(PROJ + (size_t)(c * 64 + l) * NAB_BF + PV_ + h * 128 + v8);
          const unsigned vs[4] = {vv.x, vv.y, vv.z, vv.w};
#pragma unroll
          for (int e = 0; e < 4; ++e) { Vt[(v8 + 2 * e) * 72 + l] = (bf16_t)(vs[e] & 0xffffu); Vt[(v8 + 2 * e + 1) * 72 + l] = (bf16_t)(vs[e] >> 16); } }
        __syncthreads();
        { float off = 0.f, tot = 0.f;
#pragma unroll
          for (int j = 0; j < 4; ++j) { const float pj = part[j * 128 + k]; tot += pj; if (j < lq) off += pj; }
          float run = off;
#pragma unroll
          for (int i = 0; i < 16; ++i) { run += lf[i]; KEt[k * 72 + lq * 16 + i] = f2bf(kk[i] * __expf(tot - run)); }
          if (lq == 0) CDH[(size_t)(c * 16 + h) * 128 + k] = __expf(tot); }
        __syncthreads();
        { const int v0 = w * 16; const bf16x8 a0 = frag(Vt, 72, v0, 0, lane), a1 = frag(Vt, 72, v0, 32, lane);
#pragma unroll
          for (int i = 0; i < 8; ++i) { const int k0 = i * 16; f32x4 acc = {0.f, 0.f, 0.f, 0.f};
            MMA_T(acc, a0, frag(KEt, 72, k0, 0, lane)); MMA_T(acc, a1, frag(KEt, 72, k0, 32, lane));
            *(f32x4*)(STH + ((size_t)(c * 16 + h) * 128 + v0 + (lane & 15)) * 128 + k0 + 4 * (lane >> 4)) = acc; } }
        __syncthreads();
    }
}
__device__ __forceinline__ void scan_phase(float* STS, const float* CDS, float* STH, const float* CDH) {
    int tq = threadIdx.x; asm volatile("" : "+v"(tq)); const int gt = blockIdx.x * NTHR + tq, ng = gridDim.x * NTHR;
    for (int e2 = gt; e2 < 131072; e2 += ng) {
        const int e = e2 * 2;
        { const int h = e >> 13; f32x2 carry = {0.f, 0.f};
#pragma unroll 8
          for (int c = 0; c < 128; ++c) { f32x2* p = (f32x2*)(STS + (size_t)c * 262144 + e); const f32x2 s = *p; const float d = CDS[c * 32 + h]; *p = carry; carry = carry * d + s; } }
        { const int h = e >> 14, k = e & 127; f32x2 carry = {0.f, 0.f};
#pragma unroll 8
          for (int c = 0; c < 128; ++c) { f32x2* p = (f32x2*)(STH + (size_t)c * 262144 + e); const f32x2 s = *p; const f32x2 d = *(const f32x2*)(CDH + (size_t)(c * 16 + h) * 128 + k); *p = carry; carry = carry * d + s; } }
    }
}
__device__ __forceinline__ void ssd_out(const bf16_t* XC, const bf16_t* PROJ, const float* AUX, const float* dt_bias, const float* a_log, const float* dskip, const float* normw,
                                        const float* STS, bf16_t* Y, unsigned char* lds) {
    bf16_t* Cs = (bf16_t*)lds;
    bf16_t* Bs = (bf16_t*)(lds + 17408);
    float* CB = (float*)(lds + 34816);
    bf16_t* Wm = (bf16_t*)(lds + 51456);
    bf16_t* XDt = (bf16_t*)(lds + 60672);
    bf16_t* PVs = (bf16_t*)(lds + 69888);
    float* dts = (float*)(lds + 87296);
    float* cums = dts + 64; float* ss = cums + 64;
    int t = threadIdx.x; asm volatile("" : "+v"(t)); const int lane = t & 63, w = t >> 6, r = lane & 15, q4 = lane >> 4;
    for (int it = blockIdx.x; it < 128 * 4; it += gridDim.x) {
        const int c = it >> 2, g = it & 3;
#pragma unroll
        for (int i = 0; i < 2; ++i) { const int l = (t >> 4) + 32 * i, n8 = (t & 15) * 8; const bf16_t* src = XC + (size_t)(c * 64 + l) * 3072 + 2048 + g * 128 + n8;
            *(u32x4*)(Bs + l * 136 + n8) = *(const u32x4*)src; *(u32x4*)(Cs + l * 136 + n8) = *(const u32x4*)(src + 512); }
        if (t < 64) ss[t] = 0.f;
        __syncthreads();
        { const int l0 = (w & 3) * 16;
#pragma unroll
          for (int i = 0; i < 2; ++i) { const int s0 = ((w >> 2) * 2 + i) * 16; f32x4 acc = {0.f, 0.f, 0.f, 0.f};
#pragma unroll
            for (int ks = 0; ks < 4; ++ks) MMA_T(acc, frag(Cs, 136, l0, ks * 32, lane), frag(Bs, 136, s0, ks * 32, lane));
#pragma unroll
            for (int j = 0; j < 4; ++j) CB[(l0 + r) * 65 + s0 + 4 * q4 + j] = acc[j]; } }
#pragma unroll 1
        for (int hh = 0; hh < 8; ++hh) {
            const int h = g * 8 + hh;
            ssd_dtcum(AUX, dt_bias, a_log, c, h, dts, cums);
            __syncthreads();
            { const int l = t >> 3, s8 = (t & 7) * 8; const float cl = cums[l]; float wv[8];
#pragma unroll
              for (int e = 0; e < 8; ++e) { const int s = s8 + e; wv[e] = (l >= s) ? CB[l * 65 + s] * __expf(cl - cums[s]) : 0.f; }
              u32x4 pk; pk.x = cvt_pk_bf16(wv[0], wv[1]); pk.y = cvt_pk_bf16(wv[2], wv[3]); pk.z = cvt_pk_bf16(wv[4], wv[5]); pk.w = cvt_pk_bf16(wv[6], wv[7]);
              *(u32x4*)(Wm + l * 72 + s8) = pk; }
            { const int s = t >> 3, p8 = (t & 7) * 8; const float sc = dts[s];
              const u32x4 xv = *(const u32x4*)(XC + (size_t)(c * 64 + s) * 3072 + h * 64 + p8);
              const unsigned xs[4] = {xv.x, xv.y, xv.z, xv.w};
#pragma unroll
              for (int e = 0; e < 4; ++e) { XDt[(p8 + 2 * e) * 72 + s] = f2bf(bflo(xs[e]) * sc); XDt[(p8 + 2 * e + 1) * 72 + s] = f2bf(bfhi(xs[e]) * sc); } }
#pragma unroll
            for (int i = 0; i < 4; ++i) { const int p = (t >> 5) + 16 * i, n4 = (t & 31) * 4;
              const f32x4 sv = *(const f32x4*)(STS + ((size_t)(c * 32 + h) * 64 + p) * 128 + n4);
              u32x2 pk; pk.x = cvt_pk_bf16(sv[0], sv[1]); pk.y = cvt_pk_bf16(sv[2], sv[3]); *(u32x2*)(PVs + p * 136 + n4) = pk; }
            __syncthreads();
            { const int l0 = (w & 3) * 16, l = l0 + r; const float el = __expf(cums[l]), dsk = dskip[h]; const size_t tok = (size_t)(c * 64 + l);
              const bf16x8 w0 = frag(Wm, 72, l0, 0, lane), w1 = frag(Wm, 72, l0, 32, lane);
              bf16x8 cf[4];
#pragma unroll
              for (int ks = 0; ks < 4; ++ks) cf[ks] = frag(Cs, 136, l0, ks * 32, lane);
#pragma unroll
              for (int i = 0; i < 2; ++i) { const int p0 = ((w >> 2) * 2 + i) * 16; f32x4 ad = {0.f, 0.f, 0.f, 0.f}, ao = {0.f, 0.f, 0.f, 0.f};
                MMA_T(ad, w0, frag(XDt, 72, p0, 0, lane)); MMA_T(ad, w1, frag(XDt, 72, p0, 32, lane));
#pragma unroll
                for (int ks = 0; ks < 4; ++ks) MMA_T(ao, cf[ks], frag(PVs, 136, p0, ks * 32, lane));
                const int pc = h * 64 + p0 + 4 * q4;
                const u32x2 xv = *(const u32x2*)(XC + tok * 3072 + pc), zv = *(const u32x2*)(PROJ + tok * NAB_BF + PZ + pc);
                const float xf[4] = {bflo(xv.x), bfhi(xv.x), bflo(xv.y), bfhi(xv.y)}, zf[4] = {bflo(zv.x), bfhi(zv.x), bflo(zv.y), bfhi(zv.y)};
                float y[4], sq = 0.f;
#pragma unroll
                for (int j = 0; j < 4; ++j) { y[j] = (ad[j] + el * ao[j] + dsk * xf[j]) * siluf_(zf[j]); sq += y[j] * y[j]; }
                sq += __shfl_xor(sq, 16); sq += __shfl_xor(sq, 32);
                if (q4 == 0) atomicAdd(&ss[l], sq);
                u32x2 pk; pk.x = cvt_pk_bf16(y[0], y[1]); pk.y = cvt_pk_bf16(y[2], y[3]); *(u32x2*)(Y + tok * 4096 + pc) = pk; } }
            __syncthreads();
        }
        { const int l0 = (w & 3) * 16, l = l0 + r; const float rstd = rsqrtf(ss[l] * (1.0f / 512.0f) + EPS); const size_t tok = (size_t)(c * 64 + l);
#pragma unroll 1
          for (int hh = 0; hh < 8; ++hh)
#pragma unroll
            for (int i = 0; i < 2; ++i) { const int pc = (g * 8 + hh) * 64 + ((w >> 2) * 2 + i) * 16 + 4 * q4; u32x2* yp = (u32x2*)(Y + tok * 4096 + pc); const u32x2 yv = *yp; const f32x4 nw = *(const f32x4*)(normw + pc);
              u32x2 pk; pk.x = cvt_pk_bf16(bflo(yv.x) * rstd * nw[0], bfhi(yv.x) * rstd * nw[1]); pk.y = cvt_pk_bf16(bflo(yv.y) * rstd * nw[2], bfhi(yv.y) * rstd * nw[3]); *yp = pk; } }
        __syncthreads();
    }
}
__device__ __forceinline__ void hgrn_out(const bf16_t* PROJ, const float* lbl, const float* normw, const float* STH, bf16_t* Y, unsigned char* lds) {
    bf16_t* QR = (bf16_t*)lds;
    bf16_t* KR = (bf16_t*)(lds + 17408);
    bf16_t* QD = (bf16_t*)(lds + 34816);
    bf16_t* ATT = (bf16_t*)(lds + 52224);
    bf16_t* Vt = (bf16_t*)(lds + 61440);
    bf16_t* PT = (bf16_t*)(lds + 79872);
    float* part = (float*)(lds + 114688);
    float* ss = part + 512;
    int t = threadIdx.x; asm volatile("" : "+v"(t)); const int lane = t & 63, w = t >> 6, r = lane & 15, q4 = lane >> 4, k = t & 127, lq = t >> 7;
    for (int it = blockIdx.x; it < 128 * 16; it += gridDim.x) {
        const int c = it >> 4, h = it & 15;
        const float lb = hgrn_lb(lbl, h * 128 + k);
        float lf[16], kk[16], s = 0.f;
#pragma unroll
        for (int i = 0; i < 16; ++i) { const int l = lq * 16 + i; const float fr = bf2f(PROJ[(size_t)(c * 64 + l) * NAB_BF + PF + h * 128 + k]);
            const float f = lb + (1.0f - lb) * sigmoidf_(fr); kk[i] = 1.0f - f; lf[i] = __logf(f); s += lf[i]; }
        part[lq * 128 + k] = s;
        if (t < 64) ss[t] = 0.f;
#pragma unroll
        for (int i = 0; i < 2; ++i) { const int l = (t >> 4) + 32 * i, v8 = (t & 15) * 8;
          const u32x4 vv = *(const u32x4*)(PROJ + (size_t)(c * 64 + l) * NAB_BF + PV_ + h * 128 + v8);
          const unsigned vs[4] = {vv.x, vv.y, vv.z, vv.w};
#pragma unroll
          for (int e = 0; e < 4; ++e) { Vt[(v8 + 2 * e) * 72 + l] = (bf16_t)(vs[e] & 0xffffu); Vt[(v8 + 2 * e + 1) * 72 + l] = (bf16_t)(vs[e] >> 16); } }
#pragma unroll
        for (int i = 0; i < 8; ++i) { const int v = (t >> 5) + 16 * i, k4 = (t & 31) * 4;
          const f32x4 sv = *(const f32x4*)(STH + ((size_t)(c * 16 + h) * 128 + v) * 128 + k4);
          u32x2 pk; pk.x = cvt_pk_bf16(sv[0], sv[1]); pk.y = cvt_pk_bf16(sv[2], sv[3]); *(u32x2*)(PT + v * 136 + k4) = pk; }
        __syncthreads();
        { float off = 0.f;
#pragma unroll
          for (int j = 0; j < 4; ++j) { const float pj = part[j * 128 + k]; if (j < lq) off += pj; }
          const float mid = part[k] + part[128 + k];
          float run = off;
#pragma unroll
          for (int i = 0; i < 16; ++i) { run += lf[i]; const int l = lq * 16 + i;
            const float qf = siluf_(bf2f(PROJ[(size_t)(c * 64 + l) * NAB_BF + PQ + h * 128 + k]));
            QR[l * 136 + k] = f2bf(qf * __expf(run - mid)); KR[l * 136 + k] = f2bf(kk[i] * __expf(mid - run)); QD[l * 136 + k] = f2bf(qf * __expf(run)); } }
        __syncthreads();
        { const int l0 = (w & 3) * 16, l = l0 + r;
#pragma unroll
          for (int i = 0; i < 2; ++i) { const int s0 = ((w >> 2) * 2 + i) * 16; f32x4 acc = {0.f, 0.f, 0.f, 0.f};
#pragma unroll
            for (int ks = 0; ks < 4; ++ks) MMA_T(acc, frag(QR, 136, l0, ks * 32, lane), frag(KR, 136, s0, ks * 32, lane));
            const int sb = s0 + 4 * q4;
            u32x2 pk; pk.x = cvt_pk_bf16(l >= sb ? acc[0] : 0.f, l >= sb + 1 ? acc[1] : 0.f); pk.y = cvt_pk_bf16(l >= sb + 2 ? acc[2] : 0.f, l >= sb + 3 ? acc[3] : 0.f);
            *(u32x2*)(ATT + l * 72 + sb) = pk; } }
        __syncthreads();
        { const int l0 = (w & 3) * 16, l = l0 + r; const size_t tok = (size_t)(c * 64 + l);
          const bf16x8 a0 = frag(ATT, 72, l0, 0, lane), a1 = frag(ATT, 72, l0, 32, lane);
          bf16x8 qd[4];
#pragma unroll
          for (int ks = 0; ks < 4; ++ks) qd[ks] = frag(QD, 136, l0, ks * 32, lane);
          f32x4 acc[4]; float sq = 0.f;
#pragma unroll
          for (int i = 0; i < 4; ++i) { const int v0 = ((w >> 2) * 4 + i) * 16; acc[i] = (f32x4){0.f, 0.f, 0.f, 0.f};
            MMA_T(acc[i], a0, frag(Vt, 72, v0, 0, lane)); MMA_T(acc[i], a1, frag(Vt, 72, v0, 32, lane));
#pragma unroll
            for (int ks = 0; ks < 4; ++ks) MMA_T(acc[i], qd[ks], frag(PT, 136, v0, ks * 32, lane));
            sq += acc[i][0] * acc[i][0] + acc[i][1] * acc[i][1] + acc[i][2] * acc[i][2] + acc[i][3] * acc[i][3]; }
          sq += __shfl_xor(sq, 16); sq += __shfl_xor(sq, 32);
          if (q4 == 0) atomicAdd(&ss[l], sq);
          __syncthreads();
          const float rstd = rsqrtf(ss[l] * (1.0f / 128.0f) + EPS);
#pragma unroll
          for (int i = 0; i < 4; ++i) { const int vc = h * 128 + ((w >> 2) * 4 + i) * 16 + 4 * q4;
            const u32x2 gv = *(const u32x2*)(PROJ + tok * NAB_BF + PG + vc); const f32x4 nw = *(const f32x4*)(normw + vc);
            u32x2 pk; pk.x = cvt_pk_bf16(acc[i][0] * rstd * nw[0] * siluf_(bflo(gv.x)), acc[i][1] * rstd * nw[1] * siluf_(bfhi(gv.x)));
            pk.y = cvt_pk_bf16(acc[i][2] * rstd * nw[2] * siluf_(bflo(gv.y)), acc[i][3] * rstd * nw[3] * siluf_(bfhi(gv.y)));
            *(u32x2*)(Y + tok * 4096 + 2048 + vc) = pk; } }
        __syncthreads();
    }
}
__device__ __forceinline__ void dcum_phase(const float* FAUX, const float* b_f, float* DCUM, unsigned char* lds) {
    float* part = (float*)lds;
    int t = threadIdx.x; asm volatile("" : "+v"(t));
    for (int hd = blockIdx.x; hd < 16; hd += gridDim.x) {
        float v[16], s = 0.f; const float bf = b_f[hd];
#pragma unroll
        for (int i = 0; i < 16; ++i) { const float x = FAUX[(size_t)(t * 16 + i) * 256 + hd] + bf; s += fminf(x, 0.f) - log1pf(__expf(-fabsf(x))); v[i] = s; }
        part[t] = s;
        __syncthreads();
        float off = 0.f;
        for (int j = 0; j < t; ++j) off += part[j];
#pragma unroll
        for (int i = 0; i < 16; ++i) DCUM[(size_t)hd * T + t * 16 + i] = off + v[i];
        __syncthreads();
    }
}
__device__ __forceinline__ void fox_attn(const bf16_t* QKV, const float* DCUM, bf16_t* O, unsigned char* lds) {
    bf16_t* Ks = (bf16_t*)lds;
    bf16_t* Vt = (bf16_t*)(lds + 17408);
    int t = threadIdx.x; asm volatile("" : "+v"(t)); const int lane = t & 63, w = t >> 6, r = lane & 15, q4 = lane >> 4;
    const float LOG2E = 1.44269504088896f, SC2 = 0.08838834764831845f * LOG2E;
    for (int it = blockIdx.x; it < 1024; it += gridDim.x) {
        const int rnd = it >> 8, b = it & 255, jj = b >> 4, hd = b & 15;
        const int qb = rnd == 0 ? 63 - jj : (rnd == 1 ? 32 + jj : (rnd == 2 ? 31 - jj : jj));
        const int q0 = qb * 128, row = q0 + w * 16 + r;
        bf16x8 qf[4];
#pragma unroll
        for (int ks = 0; ks < 4; ++ks) qf[ks] = *(const bf16x8*)(QKV + (size_t)row * NFOX_BF + hd * 128 + ks * 32 + q4 * 8);
        const float dq = DCUM[(size_t)hd * T + row] * LOG2E;
        float m = -INFINITY, lsum = 0.f;
        f32x4 oacc[8];
#pragma unroll
        for (int i = 0; i < 8; ++i) oacc[i] = (f32x4){0.f, 0.f, 0.f, 0.f};
        const int nkt = 2 * qb + 2;
        for (int kt = 0; kt < nkt; ++kt) {
            const int k0 = kt * 64;
            __syncthreads();
            { const int key = t >> 3, d16 = (t & 7) * 16; const bf16_t* kp = QKV + (size_t)(k0 + key) * NFOX_BF + 2048 + hd * 128 + d16;
              *(u32x4*)(Ks + key * 136 + d16) = *(const u32x4*)kp; *(u32x4*)(Ks + key * 136 + d16 + 8) = *(const u32x4*)(kp + 8);
              const u32x4 va = *(const u32x4*)(kp + 2048), vb = *(const u32x4*)(kp + 2048 + 8);
              const int kq = key & 31, slot = (key & 32) + ((kq >> 2) & 3) * 8 + (kq >> 4) * 4 + (kq & 3);
              const unsigned vs[8] = {va.x, va.y, va.z, va.w, vb.x, vb.y, vb.z, vb.w};
#pragma unroll
              for (int e = 0; e < 8; ++e) { Vt[(d16 + 2 * e) * 72 + slot] = (bf16_t)(vs[e] & 0xffffu); Vt[(d16 + 2 * e + 1) * 72 + slot] = (bf16_t)(vs[e] >> 16); } }
            __syncthreads();
            f32x4 sc[4]; float mx = -INFINITY;
            const bool diag = (k0 + 63 > q0 + w * 16);
#pragma unroll
            for (int nt = 0; nt < 4; ++nt) { sc[nt] = (f32x4){0.f, 0.f, 0.f, 0.f};
#pragma unroll
              for (int ks = 0; ks < 4; ++ks) sc[nt] = __builtin_amdgcn_mfma_f32_16x16x32_bf16(frag(Ks, 136, nt * 16, ks * 32, lane), qf[ks], sc[nt], 0, 0, 0);
              const int kb = k0 + nt * 16 + 4 * q4; const f32x4 dk = *(const f32x4*)(DCUM + (size_t)hd * T + kb);
#pragma unroll
              for (int j = 0; j < 4; ++j) { float v = sc[nt][j] * SC2 + (dq - dk[j] * LOG2E); if (diag && (kb + j > row)) v = -INFINITY; sc[nt][j] = v; mx = fmaxf(mx, v); } }
            mx = fmaxf(mx, __shfl_xor(mx, 16)); mx = fmaxf(mx, __shfl_xor(mx, 32));
            const float mn = fmaxf(m, mx), alpha = exp2f(m - mn); m = mn;
            float ps = 0.f;
#pragma unroll
            for (int nt = 0; nt < 4; ++nt)
#pragma unroll
              for (int j = 0; j < 4; ++j) { const float p = exp2f(sc[nt][j] - mn); sc[nt][j] = p; ps += p; }
            lsum = lsum * alpha + ps;
#pragma unroll
            for (int i = 0; i < 8; ++i) oacc[i] *= alpha;
#pragma unroll
            for (int k2 = 0; k2 < 2; ++k2) {
              union { bf16x8 v; unsigned u[4]; } pf;
              pf.u[0] = cvt_pk_bf16(sc[2 * k2][0], sc[2 * k2][1]); pf.u[1] = cvt_pk_bf16(sc[2 * k2][2], sc[2 * k2][3]);
              pf.u[2] = cvt_pk_bf16(sc[2 * k2 + 1][0], sc[2 * k2 + 1][1]); pf.u[3] = cvt_pk_bf16(sc[2 * k2 + 1][2], sc[2 * k2 + 1][3]);
#pragma unroll
              for (int i = 0; i < 8; ++i) oacc[i] = __builtin_amdgcn_mfma_f32_16x16x32_bf16(frag(Vt, 72, i * 16, k2 * 32, lane), pf.v, oacc[i], 0, 0, 0);
            }
        }
        lsum += __shfl_xor(lsum, 16); lsum += __shfl_xor(lsum, 32);
        const float inv = 1.0f / lsum;
#pragma unroll
        for (int i = 0; i < 8; ++i) { u32x2 pk; pk.x = cvt_pk_bf16(oacc[i][0] * inv, oacc[i][1] * inv); pk.y = cvt_pk_bf16(oacc[i][2] * inv, oacc[i][3] * inv);
          *(u32x2*)(O + (size_t)row * D + hd * 128 + i * 16 + 4 * q4) = pk; }
    }
}

template <class Epi>
__device__ __forceinline__ void run_gemm(unsigned char* lds, const bf16_t* A, const bf16_t* Bt, int N, int K, const Epi& E) {
    int Mv = T, Nv = N, Kv = K; asm volatile("" : "+s"(Mv), "+s"(Nv), "+s"(Kv)); Gemm g{A, Bt, Mv, Nv, Kv}; StaticOrder S; S.init(Mv, Nv, (int)gridDim.x, (int)blockIdx.x);
    gemm_phase<Epi, StaticOrder, false>((PG8_LAS unsigned char*)lds, g, S, E, nullptr);
}
constexpr int NPHASES = 33;
__global__ void __launch_bounds__(NTHR) mega(Params P) {
    extern __shared__ __attribute__((aligned(16))) unsigned char lds[];
    cg::grid_group grid = cg::this_grid();
    unsigned char* ws = P.ws;
    float* H = (float*)(ws + OFF_H); bf16_t* XN = (bf16_t*)(ws + OFF_XN); bf16_t* WB0 = (bf16_t*)(ws + OFF_WB0); bf16_t* WB1 = (bf16_t*)(ws + OFF_WB1);
    bf16_t* ACT = (bf16_t*)(ws + OFF_ACT);
    bf16_t* PROJ = (bf16_t*)(ws + OFF_PROJ); float* AUX = (float*)(ws + OFF_AUX); bf16_t* XC = (bf16_t*)(ws + OFF_XC);
    float* STS = (float*)(ws + OFF_STS); float* STH = (float*)(ws + OFF_STH); bf16_t* Y = (bf16_t*)(ws + OFF_Y); float* CDS = (float*)(ws + OFF_CDS); float* CDH = (float*)(ws + OFF_CDH);
    bf16_t* QKV = (bf16_t*)(ws + OFF_QKV); float* FAUX = (float*)(ws + OFF_FAUX); float* DCUM = (float*)(ws + OFF_DCUM); bf16_t* OB = (bf16_t*)(ws + OFF_O);
    bf16_t* PB = (bf16_t*)(ws + OFF_PB); float* EB = (float*)(ws + OFF_E); float* RSTD = (float*)(ws + OFF_RSTD);
    int ph = 0;
#define PHASE_BEGIN if (ph >= P.ph_lo && ph < P.ph_hi) { if (ph > P.ph_lo) grid.sync();
#define PHASE_END } ++ph;
#pragma unroll 1
    for (int L = 0; L < 2; ++L) {
#pragma unroll 1
        for (int f = 0; f < 2; ++f) {
            if (f == 1) {
                PHASE_BEGIN
                    rmsnorm_phase<false>(H, P.in[5] + L * D, XN, nullptr);
                    if (L == 0) { convert_w(P.in[6], D, 13344, WB0, NAB, 2, lds); convert_w(P.in[15], 4096, D, WB1, D, 0, lds); }
                    else { convert_w(P.in[16], D, 6160, WB0, NFOX, 0, lds); convert_w(P.in[18], D, D, WB1, D, 0, lds); }
                PHASE_END
                if (L == 0) {
                    PHASE_BEGIN { EpiProj E{PROJ, NAB_BF, NAB_BF / 256, AUX}; run_gemm(lds, XN, WB0, NAB, D, E); } PHASE_END
                    PHASE_BEGIN conv_phase(PROJ, P.in[7], P.in[8], XC); PHASE_END
                    PHASE_BEGIN ssd_states(XC, AUX, P.in[9], P.in[10], STS, CDS, lds); hgrn_states(PROJ, P.in[13], STH, CDH, lds); PHASE_END
                    PHASE_BEGIN scan_phase(STS, CDS, STH, CDH); PHASE_END
                    PHASE_BEGIN ssd_out(XC, PROJ, AUX, P.in[9], P.in[10], P.in[11], P.in[12], STS, Y, lds); hgrn_out(PROJ, P.in[13], P.in[14], STH, Y, lds); PHASE_END
                    PHASE_BEGIN { EpiResid E{H, H, D, 1.0f}; run_gemm(lds, Y, WB1, D, 4096, E); } PHASE_END
                } else {
                    PHASE_BEGIN { EpiProj E{QKV, NFOX_BF, NFOX_BF / 256, FAUX}; run_gemm(lds, XN, WB0, NFOX, D, E); } PHASE_END
                    PHASE_BEGIN dcum_phase(FAUX, P.in[17], DCUM, lds); PHASE_END
                    PHASE_BEGIN fox_attn(QKV, DCUM, OB, lds); PHASE_END
                    PHASE_BEGIN { EpiResid E{H, H, D, 1.0f}; run_gemm(lds, OB, WB1, D, D, E); } PHASE_END
                }
            }
            const int bi = f == 0 ? 2 : 19;
            const float* hsrc = (L == 0 && f == 0) ? P.in[0] : H;
            PHASE_BEGIN
                rmsnorm_phase<false>(hsrc, P.in[bi] + L * D, XN, nullptr);
                convert_w(P.in[bi + 1] + (size_t)L * D * NFF, D, NFF, WB0, NFF, 1, lds);
                convert_w(P.in[bi + 2] + (size_t)L * DFF * D, DFF, D, WB1, D, 0, lds);
            PHASE_END
            PHASE_BEGIN { EpiSwiGLU E{ACT, DFF}; run_gemm(lds, XN, WB0, NFF, D, E); } PHASE_END
            PHASE_BEGIN { EpiResid E{hsrc, H, D, 0.5f}; run_gemm(lds, ACT, WB1, D, DFF, E); } PHASE_END
        }
        PHASE_BEGIN
            rmsnorm_phase<false>(H, P.in[22] + L * D, XN, nullptr);
            convert_w(P.in[23] + (size_t)L * D * D, D, D, WB0, D, 0, lds);
            convert_w(P.in[24] + (size_t)L * 256 * D, 256, D, WB1, D, 0, lds);
            convert_flat(P.in[1] + (size_t)L * T * 256, PB, T * 256);
        PHASE_END
        PHASE_BEGIN { EpiStoreF32 E{EB, D}; run_gemm(lds, PB, WB1, D, 256, E); } PHASE_END
        PHASE_BEGIN rowrstd_phase(EB, RSTD); PHASE_END
        PHASE_BEGIN { EpiPle E{EB, RSTD, P.in[25] + L * D, H, D}; run_gemm(lds, XN, WB0, D, D, E); } PHASE_END
    }
    PHASE_BEGIN rmsnorm_phase<true>(H, P.in[26], nullptr, P.out); PHASE_END
}

extern "C" void kernel_launch(void* const* d_in, const int* in_sizes, int n_in, void* d_out, int out_size, void* d_ws, size_t ws_size, hipStream_t stream) {
    static int grid = 0;
    if (grid == 0) {
        if (n_in != 27 || ws_size < WS_END) { fprintf(stderr, "kernel_launch: need 27 inputs and %zu bytes of workspace (got %d, %zu)\n", (size_t)WS_END, n_in, ws_size); grid = -1; return; }
        int dev = 0, cus = 0, per_cu = 0;
        (void)hipGetDevice(&dev); (void)hipDeviceGetAttribute(&cus, hipDeviceAttributeMultiprocessorCount, dev);
        if (hipFuncSetAttribute((const void*)mega, hipFuncAttributeMaxDynamicSharedMemorySize, LDS_BYTES) != hipSuccess) { fprintf(stderr, "kernel_launch: hipFuncSetAttribute failed\n"); grid = -1; return; }
        if (hipOccupancyMaxActiveBlocksPerMultiprocessor(&per_cu, (const void*)mega, NTHR, LDS_BYTES) != hipSuccess || per_cu < 1) { fprintf(stderr, "kernel_launch: occupancy query says %d\n", per_cu); per_cu = 1; }
        (void)hipGetLastError();
        grid = cus * 1;
    }
    if (grid < 0) return;
    Params p{};
    for (int i = 0; i < 27; ++i) p.in[i] = (const float*)d_in[i];
    p.out = (float*)d_out; p.ws = (unsigned char*)d_ws;
#if ONE_LAUNCH
    p.ph_lo = 0; p.ph_hi = NPHASES;
    void* args[] = {&p};
    hipError_t e = hipLaunchCooperativeKernel((const void*)mega, dim3(grid), dim3(NTHR), args, LDS_BYTES, stream);
    if (e != hipSuccess) fprintf(stderr, "cooperative launch failed: %s (grid %d)\n", hipGetErrorString(e), grid);
#else
    for (int ph = 0; ph < NPHASES; ++ph) { p.ph_lo = ph; p.ph_hi = ph + 1; hipLaunchKernelGGL(mega, dim3(grid), dim3(NTHR), LDS_BYTES, stream, p); }
#endif
}
```

```cpp
#include <hip/hip_runtime.h>
#include <hip/hip_cooperative_groups.h>
#include <cstdio>
namespace cg = cooperative_groups;
#ifndef ONE_LAUNCH
#define ONE_LAUNCH 1
#endif
namespace pg8 {
#define PG8_LAS __attribute__((address_space(3)))
typedef unsigned short bf16_t;
typedef short bf16x8 __attribute__((ext_vector_type(8)));
typedef float f32x4 __attribute__((ext_vector_type(4)));
typedef unsigned u32x4 __attribute__((ext_vector_type(4)));
constexpr int BM = 256, BK = 64, HALF = 128, HTB = HALF * BK * 2  , STAGE_BYTES = 8 * HTB, NXCD = 8, WGM = 4;

__host__ __device__ __forceinline__ int lds_byte(int r, int c) { const int st = (r >> 4) * 2 + (c >> 5), rr = r & 15, cc = c & 31, ob = rr * 64 + cc * 2; return st * 1024 + (ob ^ (((ob >> 9) & 1) << 5)); }
__host__ __device__ __forceinline__ void stage_rc(int b, int& R, int& C) { const int st = b / 1024, sb = b % 1024, swz = sb ^ (((sb >> 9) & 1) << 5); R = (st >> 1) * 16 + swz / 64; C = (st & 1) * 32 + (swz % 64) / 2; }
__host__ __device__ __forceinline__ int perm32(int rho) { const int n = rho >> 4, i = rho & 15; return 8 * (i >> 2) + 4 * n + (i & 3); }

struct Unit { int pm, pn; };
struct Gemm { const bf16_t* A; const bf16_t* Bt; int M, N, K; };

struct StaticOrder {
    int nM, nN, nwg, G, c;
    __host__ __device__ void init(int M, int N, int G_, int c_) { nM = M / BM; nN = N / BM; nwg = nM * nN; G = G_; c = c_; }
    __host__ __device__ bool next(int i, Unit& u) const {
        const long L = (long)i * G + c; if (L >= nwg) return false;
        int wgid = (int)L; { const int q = nwg / NXCD, r = nwg % NXCD, xcd = wgid % NXCD, off = wgid / NXCD; wgid = (xcd < r ? xcd * (q + 1) : r * (q + 1) + (xcd - r) * q) + off; }
        const int nig = WGM * nN, gid = wgid / nig, fm = gid * WGM, gsz = (nM - fm) < WGM ? (nM - fm) : WGM;
        u.pm = fm + ((wgid % nig) % gsz); u.pn = (wgid % nig) / gsz; return true;
    }
    __device__ __forceinline__ void a_ready(const Unit&) const {}
    __device__ __forceinline__ void done(const Unit&) const {}
};
typedef unsigned u32x2 __attribute__((ext_vector_type(2)));
typedef float f32x2 __attribute__((ext_vector_type(2)));
typedef __bf16 bf16x2_cv __attribute__((ext_vector_type(2)));
typedef float f32x2_cv __attribute__((ext_vector_type(2)));
__device__ __forceinline__ unsigned cvt_pk_bf16(float lo, float hi) { const f32x2_cv v = {lo, hi}; return __builtin_bit_cast(unsigned, __builtin_convertvector(v, bf16x2_cv)); }
__device__ __forceinline__ unsigned pack_bf16_sw(float lo, float hi) { return cvt_pk_bf16(lo, hi); }
__device__ __forceinline__ bf16_t f2bf(float x) { return (bf16_t)(cvt_pk_bf16(x, 0.f) & 0xffffu); }
__device__ __forceinline__ float bf2f(bf16_t b) { return __uint_as_float(((unsigned)b) << 16); }
__device__ __forceinline__ float bflo(unsigned w) { return __uint_as_float(w << 16); }
__device__ __forceinline__ float bfhi(unsigned w) { return __uint_as_float(w & 0xffff0000u); }
__device__ __forceinline__ float sigmoidf_(float x) { return __builtin_amdgcn_rcpf(1.0f + __expf(-x)); }
__device__ __forceinline__ float siluf_(float x) { return x * sigmoidf_(x); }
__device__ __forceinline__ float softplusf_(float x) { return fmaxf(x, 0.f) + log1pf(__expf(-fabsf(x))); }

__device__ __forceinline__ void load_rows8(float (&rsv)[8], const float* p0, const float* p1) {
    asm volatile("global_load_dword %0, %8, off\n\tglobal_load_dword %1, %8, off offset:64\n\tglobal_load_dword %2, %8, off offset:128\n\tglobal_load_dword %3, %8, off offset:192\n\t"
                 "global_load_dword %4, %9, off\n\tglobal_load_dword %5, %9, off offset:64\n\tglobal_load_dword %6, %9, off offset:128\n\tglobal_load_dword %7, %9, off offset:192\n\t"
                 "s_waitcnt vmcnt(0)"
                 : "=&v"(rsv[0]), "=&v"(rsv[1]), "=&v"(rsv[2]), "=&v"(rsv[3]), "=&v"(rsv[4]), "=&v"(rsv[5]), "=&v"(rsv[6]), "=&v"(rsv[7]) : "v"(p0), "v"(p1) : "memory");
}
struct EpiSwiGLU {
    static constexpr bool PERM = true, AFTER_DRAIN = false;
    bf16_t* O; int ldc; const float* rsr;
    __device__ __forceinline__ void operator()(const f32x4 (&acc)[2][2][4][2], const Unit& u, int wr, int wc, int fr, int fq) const {
        const int row0 = u.pm * BM + wr * 64 + fr, col0 = u.pn * 128 + wc * 32 + 8 * fq;
        float rsv[8]; load_rows8(rsv, rsr + row0, rsr + row0 + HALF);
#pragma unroll
        for (int ai = 0; ai < 2; ++ai)
#pragma unroll
            for (int m = 0; m < 4; ++m) {
                bf16_t* rowp = O + (size_t)(row0 + ai * HALF + m * 16) * ldc + col0;
                f32x4 v0, v1; const float rs = rsv[ai * 4 + m];
#pragma unroll
                for (int j = 0; j < 4; ++j) { v0[j] = siluf_(acc[ai][0][m][0][j] * rs) * (acc[ai][1][m][0][j] * rs); v1[j] = siluf_(acc[ai][0][m][1][j] * rs) * (acc[ai][1][m][1][j] * rs); }
                u32x4 w; w.x = cvt_pk_bf16(v0[0], v0[1]); w.y = cvt_pk_bf16(v0[2], v0[3]); w.z = cvt_pk_bf16(v1[0], v1[1]); w.w = cvt_pk_bf16(v1[2], v1[3]);
                *(u32x4*)rowp = w;
            }
    }
};
struct EpiResid {
    static constexpr bool PERM = true, AFTER_DRAIN = false;
    const bf16_t* hin; bf16_t* hout; int ldc; float alpha; float* ssp;
    __device__ __forceinline__ void operator()(const f32x4 (&acc)[2][2][4][2], const Unit& u, int wr, int wc, int fr, int fq) const {
        const int row0 = u.pm * BM + wr * 64 + fr, col0 = u.pn * BM + wc * 32 + 8 * fq;
        u32x4 b[8][2];
#pragma unroll
        for (int g = 0; g < 8; ++g) { const size_t off = (size_t)(row0 + (g >> 2) * HALF + (g & 3) * 16) * ldc + col0; b[g][0] = *(const u32x4*)(hin + off); b[g][1] = *(const u32x4*)(hin + off + HALF); }
#pragma unroll
        for (int g = 0; g < 8; ++g) { const int ai = g >> 2, m = g & 3, row = row0 + ai * HALF + m * 16; const size_t off = (size_t)row * ldc + col0;
            float sq = 0.f;
#pragma unroll
            for (int bj = 0; bj < 2; ++bj) { const u32x4 bv = b[g][bj]; const f32x4 a0 = acc[ai][bj][m][0], a1 = acc[ai][bj][m][1];
                const float r0 = bflo(bv.x) + alpha * a0[0], r1 = bfhi(bv.x) + alpha * a0[1], r2 = bflo(bv.y) + alpha * a0[2], r3 = bfhi(bv.y) + alpha * a0[3];
                const float r4 = bflo(bv.z) + alpha * a1[0], r5 = bfhi(bv.z) + alpha * a1[1], r6 = bflo(bv.w) + alpha * a1[2], r7 = bfhi(bv.w) + alpha * a1[3];
                sq += (r0 * r0 + r1 * r1) + (r2 * r2 + r3 * r3) + (r4 * r4 + r5 * r5) + (r6 * r6 + r7 * r7);
                u32x4 pk; pk.x = cvt_pk_bf16(r0, r1); pk.y = cvt_pk_bf16(r2, r3); pk.z = cvt_pk_bf16(r4, r5); pk.w = cvt_pk_bf16(r6, r7);
                *(u32x4*)(hout + off + bj * HALF) = pk; }
            sq += __shfl_xor(sq, 16); sq += __shfl_xor(sq, 32);
            if (fq == 0) ssp[(size_t)row * 32 + u.pn * 4 + wc] = sq; }
    }
};
struct EpiProj {
    static constexpr bool PERM = true, AFTER_DRAIN = false;
    bf16_t* O; int ldc; int n_bf; float* aux; const float* rsr;
    __device__ __forceinline__ void operator()(const f32x4 (&acc)[2][2][4][2], const Unit& u, int wr, int wc, int fr, int fq) const {
        const int row0 = u.pm * BM + wr * 64 + fr;
        float rsv[8]; load_rows8(rsv, rsr + row0, rsr + row0 + HALF);
        if (u.pn < n_bf) {
            const int col0 = u.pn * BM + wc * 32 + 8 * fq;
#pragma unroll
            for (int ai = 0; ai < 2; ++ai)
#pragma unroll
                for (int m = 0; m < 4; ++m) { bf16_t* rowp = O + (size_t)(row0 + ai * HALF + m * 16) * ldc + col0;
#pragma unroll
                    for (int bj = 0; bj < 2; ++bj) { const f32x4 v0 = acc[ai][bj][m][0] * rsv[ai * 4 + m], v1 = acc[ai][bj][m][1] * rsv[ai * 4 + m];
                        u32x4 w; w.x = cvt_pk_bf16(v0[0], v0[1]); w.y = cvt_pk_bf16(v0[2], v0[3]); w.z = cvt_pk_bf16(v1[0], v1[1]); w.w = cvt_pk_bf16(v1[2], v1[3]);
                        *(u32x4*)(rowp + bj * HALF) = w; } }
        } else {
            const int col0 = wc * 32 + 8 * fq;
#pragma unroll
            for (int ai = 0; ai < 2; ++ai)
#pragma unroll
                for (int m = 0; m < 4; ++m) { float* rowp = aux + (size_t)(row0 + ai * HALF + m * 16) * 256 + col0;
#pragma unroll
                    for (int bj = 0; bj < 2; ++bj)
#pragma unroll
                        for (int n = 0; n < 2; ++n) *(f32x4*)(rowp + bj * HALF + 4 * n) = acc[ai][bj][m][n] * rsv[ai * 4 + m]; }
        }
    }
};
struct EpiStoreE {
    static constexpr bool PERM = true, AFTER_DRAIN = false;
    bf16_t* C; int ldc; float* ssp;
    __device__ __forceinline__ void operator()(const f32x4 (&acc)[2][2][4][2], const Unit& u, int wr, int wc, int fr, int fq) const {
        const int row0 = u.pm * BM + wr * 64 + fr, col0 = u.pn * BM + wc * 32 + 8 * fq;
#pragma unroll
        for (int ai = 0; ai < 2; ++ai)
#pragma unroll
            for (int m = 0; m < 4; ++m) { const int row = row0 + ai * HALF + m * 16; bf16_t* rowp = C + (size_t)row * ldc + col0; float sq = 0.f;
#pragma unroll
                for (int bj = 0; bj < 2; ++bj) { const f32x4 v0 = acc[ai][bj][m][0], v1 = acc[ai][bj][m][1];
                    sq += (v0[0] * v0[0] + v0[1] * v0[1]) + (v0[2] * v0[2] + v0[3] * v0[3]) + (v1[0] * v1[0] + v1[1] * v1[1]) + (v1[2] * v1[2] + v1[3] * v1[3]);
                    u32x4 w; w.x = pack_bf16_sw(v0[0], v0[1]); w.y = pack_bf16_sw(v0[2], v0[3]); w.z = pack_bf16_sw(v1[0], v1[1]); w.w = pack_bf16_sw(v1[2], v1[3]);
                    *(u32x4*)(rowp + bj * HALF) = w; }
                sq += __shfl_xor(sq, 16); sq += __shfl_xor(sq, 32);
                if (fq == 0) ssp[(size_t)row * 32 + u.pn * 4 + wc] = sq; }
    }
};
struct EpiPle {
    static constexpr bool PERM = true, AFTER_DRAIN = false;
    const bf16_t* E; const float* rstdE; const float* wpost; const bf16_t* hin; int ldc; const float* rin; bf16_t* hout; float* ssp;
    __device__ __forceinline__ void operator()(const f32x4 (&acc)[2][2][4][2], const Unit& u, int wr, int wc, int fr, int fq) const {
        const int row0 = u.pm * BM + wr * 64 + fr, col0 = u.pn * BM + wc * 32 + 8 * fq;
#pragma unroll
        for (int g = 0; g < 8; ++g) { const int ai = g >> 2, m = g & 3, row = row0 + ai * HALF + m * 16; const size_t off = (size_t)row * ldc + col0;
            const float rs = rstdE[row], ri = rin[row];
            float sq = 0.f;
#pragma unroll
            for (int bj = 0; bj < 2; ++bj) { const u32x4 bv = *(const u32x4*)(hin + off + bj * HALF); const float bb[8] = {bflo(bv.x), bfhi(bv.x), bflo(bv.y), bfhi(bv.y), bflo(bv.z), bfhi(bv.z), bflo(bv.w), bfhi(bv.w)};
                const u32x4 ev = *(const u32x4*)(E + off + bj * HALF); const float eb[8] = {bflo(ev.x), bfhi(ev.x), bflo(ev.y), bfhi(ev.y), bflo(ev.z), bfhi(ev.z), bflo(ev.w), bfhi(ev.w)};
                float r[8];
#pragma unroll
                for (int n = 0; n < 2; ++n) { const f32x4 a = acc[ai][bj][m][n];
                    const f32x4 ww = *(const f32x4*)(wpost + col0 + bj * HALF + 4 * n);
#pragma unroll
                    for (int j = 0; j < 4; ++j) { r[4 * n + j] = bb[4 * n + j] + eb[4 * n + j] * rs * ww[j] * sigmoidf_(a[j] * ri); sq += r[4 * n + j] * r[4 * n + j]; } }
                u32x4 pk; pk.x = cvt_pk_bf16(r[0], r[1]); pk.y = cvt_pk_bf16(r[2], r[3]); pk.z = cvt_pk_bf16(r[4], r[5]); pk.w = cvt_pk_bf16(r[6], r[7]);
                *(u32x4*)(hout + off + bj * HALF) = pk; }
            sq += __shfl_xor(sq, 16); sq += __shfl_xor(sq, 32);
            if (fq == 0) ssp[(size_t)row * 32 + u.pn * 4 + wc] = sq;
            asm volatile("" ::: "memory"); }
    }
};
template <class Epi, class Sched, bool STAMP = false>
__device__ __forceinline__ void gemm_phase(PG8_LAS unsigned char* lds, const Gemm g, const Sched& S, const Epi& E, unsigned long long* stamps) {
    int tid = threadIdx.x; asm volatile("" : "+v"(tid)); const int wid = __builtin_amdgcn_readfirstlane(tid >> 6), lane = tid & 63, wr = wid >> 2, wc = wid & 3, fr = lane & 15, fq = lane >> 4;
    const int K = g.K, nt = K / BK;
    int ts_lo = 0, ts_hi = 0, nts = 0; const unsigned long long rt_entry = STAMP ? (unsigned long long)wall_clock64() : 0ull;
#define PG8_STAMP() do { if (STAMP && wid == 0 && nts < 64) { const unsigned long long _c = (unsigned long long)clock64(); \
        ts_lo = (lane == nts) ? (int)(unsigned)_c : ts_lo; ts_hi = (lane == nts) ? (int)(unsigned)(_c >> 32) : ts_hi; ++nts; } } while (0)
    PG8_STAMP();
    unsigned voffA[2], voffB[2];
#pragma unroll
    for (int i = 0; i < 2; ++i) { int R, C; stage_rc(tid * 16 + i * 8192, R, C); const int Rb = Epi::PERM ? ((R & ~31) + perm32(R & 31)) : R;
        voffA[i] = (unsigned)(R * K + C) * 2u; voffB[i] = (unsigned)(Rb * K + C) * 2u; }
    const size_t kstep = (size_t)(BK * 2);
    const size_t hstep = (size_t)HALF * K * 2;
    const size_t tstep = 2 * hstep;
    const unsigned ldsw = (unsigned)wid * 1024u;
    const int aoff = lds_byte(wr * 64 + fr, fq * 8), boff = lds_byte(wc * 32 + fr, fq * 8);
#define PG8_SA(b, h) (((b) * 2 + (h)) * HTB)
#define PG8_SB(b, h) ((4 + (b) * 2 + (h)) * HTB)
#define PG8_STAGE(bufoff, gbase, voff) do { _Pragma("unroll") for (int _i = 0; _i < 2; ++_i) \
        __builtin_amdgcn_global_load_lds((const unsigned*)((const char*)(gbase) + (voff)[_i]), (PG8_LAS unsigned*)(lds + (bufoff) + ldsw + _i * 8192), 16, 0, 0); } while (0)
#define PG8_LDA(dst, b, h) do { _Pragma("unroll") for (int m = 0; m < 4; ++m) _Pragma("unroll") for (int k = 0; k < 2; ++k) dst[m][k] = *(const PG8_LAS bf16x8*)(lds + PG8_SA(b, h) + aoff + m * 2048 + k * 1024); } while (0)
#define PG8_LDB(dst, b, h) do { _Pragma("unroll") for (int n = 0; n < 2; ++n) _Pragma("unroll") for (int k = 0; k < 2; ++k) dst[n][k] = *(const PG8_LAS bf16x8*)(lds + PG8_SB(b, h) + boff + n * 2048 + k * 1024); } while (0)
#define PG8_MMA(ai, bj, At, Bt) do { __builtin_amdgcn_s_setprio(1); _Pragma("unroll") for (int m = 0; m < 4; ++m) _Pragma("unroll") for (int n = 0; n < 2; ++n) _Pragma("unroll") for (int k = 0; k < 2; ++k) \
        acc[ai][bj][m][n] = __builtin_amdgcn_mfma_f32_16x16x32_bf16(Bt[n][k], At[m][k], acc[ai][bj][m][n], 0, 0, 0); __builtin_amdgcn_s_setprio(0); } while (0)
#define PG8_WAIT_V(n) asm volatile("s_waitcnt vmcnt(" #n ")" ::: "memory")
#define PG8_WAIT_L(n) asm volatile("s_waitcnt lgkmcnt(" #n ")" ::: "memory")
#define PG8_BAR __builtin_amdgcn_s_barrier()
#define PG8_SCHED __builtin_amdgcn_sched_barrier(0)
    Unit cur, nxt; int ui = 0;
    if (!S.next(0, cur)) return;
    f32x4 acc[2][2][4][2];
#pragma unroll
    for (int a = 0; a < 2; ++a)
#pragma unroll
        for (int b = 0; b < 2; ++b)
#pragma unroll
            for (int m = 0; m < 4; ++m)
#pragma unroll
                for (int n = 0; n < 2; ++n) acc[a][b][m][n] = (f32x4){0.f, 0.f, 0.f, 0.f};
    bf16x8 At[4][2], B0[2][2], B1[2][2];
    const char* cA = (const char*)g.A + (size_t)cur.pm * tstep; const char* cB = (const char*)g.Bt + (size_t)cur.pn * tstep;
    S.a_ready(cur);
    PG8_STAGE(PG8_SB(0, 0), cB, voffB); PG8_STAGE(PG8_SA(0, 0), cA, voffA); PG8_STAGE(PG8_SB(0, 1), cB + hstep, voffB); PG8_STAGE(PG8_SA(0, 1), cA + hstep, voffA);
    if (wr == 1) PG8_BAR;
    PG8_WAIT_V(4); PG8_BAR;
    PG8_STAGE(PG8_SB(1, 0), cB + kstep, voffB); PG8_STAGE(PG8_SA(1, 0), cA + kstep, voffA); PG8_STAGE(PG8_SB(1, 1), cB + hstep + kstep, voffB);
    PG8_WAIT_V(6); PG8_BAR;
    PG8_STAMP();
    for (;;) {
        const bool has_next = S.next(ui + 1, nxt);
        const char* nA = has_next ? (const char*)g.A + (size_t)nxt.pm * tstep : cA; const char* nB = has_next ? (const char*)g.Bt + (size_t)nxt.pn * tstep : cB;
        for (int t = 0; t < nt; t += 2) {
            const bool last = (t == nt - 2);
            const char* a1 = cA + (size_t)(t + 1) * kstep;
            const char* a2 = last ? nA : cA + (size_t)(t + 2) * kstep; const char* b2 = last ? nB : cB + (size_t)(t + 2) * kstep;
            const char* a3 = a2 + kstep; const char* b3 = b2 + kstep;
            if (last && has_next) S.a_ready(nxt);
            PG8_LDB(B0, 0, 0); PG8_SCHED; PG8_LDA(At, 0, 0); PG8_STAGE(PG8_SA(1, 1), a1 + hstep, voffA);
            PG8_WAIT_L(8); PG8_BAR; PG8_WAIT_L(0); PG8_MMA(0, 0, At, B0); PG8_BAR; PG8_SCHED;
            PG8_LDB(B1, 0, 1); PG8_STAGE(PG8_SB(0, 0), b2, voffB);
            PG8_BAR; PG8_WAIT_L(0); PG8_MMA(0, 1, At, B1); PG8_BAR;
            PG8_LDA(At, 0, 1); PG8_STAGE(PG8_SA(0, 0), a2, voffA);
            PG8_BAR; PG8_WAIT_L(0); PG8_MMA(1, 0, At, B0); PG8_BAR; PG8_SCHED;
            PG8_STAGE(PG8_SB(0, 1), b2 + hstep, voffB);
            PG8_WAIT_V(6); PG8_BAR; PG8_MMA(1, 1, At, B1); PG8_BAR;
            PG8_LDB(B0, 1, 0); PG8_SCHED; PG8_LDA(At, 1, 0); PG8_STAGE(PG8_SA(0, 1), a2 + hstep, voffA);
            PG8_WAIT_L(8); PG8_BAR; PG8_WAIT_L(0); PG8_MMA(0, 0, At, B0); PG8_BAR; PG8_SCHED;
            PG8_LDB(B1, 1, 1); PG8_STAGE(PG8_SB(1, 0), b3, voffB);
            PG8_BAR; PG8_WAIT_L(0); PG8_MMA(0, 1, At, B1); PG8_BAR;
            PG8_LDA(At, 1, 1); PG8_STAGE(PG8_SA(1, 0), a3, voffA);
            PG8_BAR; PG8_WAIT_L(0); PG8_MMA(1, 0, At, B0); PG8_BAR; PG8_SCHED;
            PG8_STAGE(PG8_SB(1, 1), b3 + hstep, voffB);
            PG8_WAIT_V(6); PG8_BAR; PG8_MMA(1, 1, At, B1); PG8_BAR;
        }
        PG8_STAMP();
        if constexpr (!Epi::AFTER_DRAIN) { E(acc, cur, wr, wc, fr, fq); S.done(cur); }
        PG8_STAMP();
        if (!has_next) break;
#pragma unroll
        for (int a = 0; a < 2; ++a)
#pragma unroll
            for (int b = 0; b < 2; ++b)
#pragma unroll
                for (int m = 0; m < 4; ++m)
#pragma unroll
                    for (int n = 0; n < 2; ++n) acc[a][b][m][n] = (f32x4){0.f, 0.f, 0.f, 0.f};
        cur = nxt; cA = nA; cB = nB; ++ui;
    }
    PG8_WAIT_V(0);
    if (wr == 0) PG8_BAR;
    PG8_BAR;
    if constexpr (Epi::AFTER_DRAIN) { E.fused(acc, cur, wr, wc, fr, fq, lds, wid, lane); S.done(cur); }
    PG8_STAMP();
    if (STAMP && wid == 0) { stamps[lane] = lane < nts ? (((unsigned long long)(unsigned)ts_hi << 32) | (unsigned)ts_lo) : 0ull;
        if (lane == 62) stamps[62] = rt_entry; if (lane == 63) stamps[63] = (unsigned long long)wall_clock64(); }
#undef PG8_STAMP
#undef PG8_SA
#undef PG8_SB
#undef PG8_STAGE
#undef PG8_LDA
#undef PG8_LDB
#undef PG8_MMA
#undef PG8_WAIT_V
#undef PG8_WAIT_L
#undef PG8_BAR
#undef PG8_SCHED
}
}
using namespace pg8;

constexpr int T = 8192, D = 2048, DFF = 5504, NFF = 2 * DFF;
constexpr int NAB = 13568, NAB_BF = 13312, NFOX = 6144, NFOX_BF = 6144;
constexpr int PZ = 0, PXBC = 2048, PQ = 5120, PF = 7168, PV_ = 9216, PG = 11264;
constexpr float EPS = 1e-6f;
constexpr int NTHR = 512;
constexpr int LDS_BYTES = 131072 + 64;
constexpr size_t OFF_H = 0, SZ_H = (size_t)T * D * 4;
constexpr size_t OFF_XN = OFF_H + SZ_H, SZ_XN = (size_t)T * D * 2;
constexpr size_t OFF_WB0 = OFF_XN + SZ_XN, SZ_WB0 = (size_t)NAB * D * 2;
constexpr size_t OFF_WB1 = OFF_WB0 + SZ_WB0, SZ_WB1 = (size_t)D * DFF * 2;
constexpr size_t OFF_WB2 = OFF_WB1 + SZ_WB1, SZ_WB2 = (size_t)D * 256 * 2;
constexpr size_t OFF_BIG = OFF_WB2 + SZ_WB2;
constexpr size_t OFF_ACT = OFF_BIG;
constexpr size_t OFF_PROJ = OFF_BIG, SZ_PROJ = (size_t)T * NAB_BF * 2;
constexpr size_t OFF_AUX = OFF_PROJ + SZ_PROJ, SZ_AUX = (size_t)T * 256 * 4;
constexpr size_t OFF_XC = OFF_AUX + SZ_AUX, SZ_XC = (size_t)T * 3072 * 2;
constexpr size_t OFF_STS = OFF_XC + SZ_XC, SZ_STS = (size_t)128 * 32 * 64 * 128 * 4;
constexpr size_t OFF_STH = OFF_STS + SZ_STS, SZ_STH = (size_t)128 * 16 * 128 * 128 * 4;
constexpr size_t OFF_Y = OFF_STH + SZ_STH, SZ_Y = (size_t)T * 4096 * 2;
constexpr size_t OFF_CDS = OFF_Y + SZ_Y, SZ_CDS = 128 * 32 * 4;
constexpr size_t OFF_CDH = OFF_CDS + SZ_CDS, SZ_CDH = 128 * 16 * 128 * 4;
constexpr size_t OFF_BAR = OFF_CDH + SZ_CDH;
constexpr size_t OFF_HB2 = OFF_BAR + 16384;
constexpr size_t OFF_RS = OFF_HB2 + SZ_XN, SZ_RS = (size_t)T * 4;
constexpr size_t OFF_SSP = OFF_RS + SZ_RS, SZ_SSP = (size_t)T * 32 * 4;
constexpr size_t OFF_SSPE = OFF_SSP + SZ_SSP;
constexpr size_t OFF_SSPB = OFF_SSPE + SZ_SSP;
constexpr size_t WS_END = OFF_SSPB + SZ_SSP;
constexpr size_t OFF_QKV = OFF_BIG, SZ_QKV = (size_t)T * NFOX_BF * 2;
constexpr size_t OFF_FAUX = OFF_QKV + SZ_QKV;
constexpr size_t OFF_DCUM = OFF_FAUX + SZ_AUX, SZ_DCUM = (size_t)256 * T * 4;
constexpr size_t OFF_O = OFF_DCUM + SZ_DCUM;
constexpr size_t OFF_VT = OFF_O + (size_t)T * D * 2;
constexpr size_t OFF_KNT = OFF_VT + (size_t)T * D * 2;
constexpr size_t OFF_PB = OFF_BIG + (size_t)96 * 1024 * 1024, SZ_PB = (size_t)T * 256 * 2;
constexpr size_t OFF_E = OFF_PB + SZ_PB, SZ_E = (size_t)T * D * 4;
constexpr size_t OFF_RSTD = OFF_E + SZ_E;

struct Params { const float* in[27]; float* out; unsigned char* ws; int ph_lo, ph_hi; };

__device__ __forceinline__ float wave_sum(float v) {
#pragma unroll
    for (int o = 32; o >= 1; o >>= 1) v += __shfl_xor(v, o);
    return v;
}
template <bool F32OUT>
__device__ __forceinline__ void rmsnorm_phase(const float* X, const float* w, bf16_t* ob, float* of) {
    int tq = threadIdx.x; asm volatile("" : "+v"(tq)); const int lane = tq & 63, gw = blockIdx.x * 8 + (tq >> 6), nw = gridDim.x * 8;
    for (int row = gw; row < T; row += nw) {
        const f32x4* xr = (const f32x4*)(X + (size_t)row * D);
        f32x4 v[8]; float ss = 0.f;
#pragma unroll
        for (int i = 0; i < 8; ++i) { v[i] = xr[lane + 64 * i]; ss += v[i][0] * v[i][0] + v[i][1] * v[i][1] + v[i][2] * v[i][2] + v[i][3] * v[i][3]; }
        ss = wave_sum(ss);
        const float rstd = rsqrtf(ss * (1.0f / D) + EPS);
#pragma unroll
        for (int i = 0; i < 8; ++i) { const f32x4 wv = ((const f32x4*)w)[lane + 64 * i]; const f32x4 y = v[i] * rstd * wv;
            if (F32OUT) ((f32x4*)(of + (size_t)row * D))[lane + 64 * i] = y;
            else { u32x2 p; p.x = cvt_pk_bf16(y[0], y[1]); p.y = cvt_pk_bf16(y[2], y[3]); ((u32x2*)(ob + (size_t)row * D))[lane + 64 * i] = p; } }
    }
}
__device__ __forceinline__ void finalnorm_phase(const bf16_t* hb, const float* w, float* out) {
    int tq = threadIdx.x; asm volatile("" : "+v"(tq)); const int lane = tq & 63, gw = blockIdx.x * 8 + (tq >> 6), nw = gridDim.x * 8;
    for (int row = gw; row < T; row += nw) {
        const u32x4* xr = (const u32x4*)(hb + (size_t)row * D); float v[32]; float sm = 0.f;
#pragma unroll
        for (int i = 0; i < 4; ++i) { const u32x4 q = xr[lane + 64 * i]; const unsigned qs[4] = {q.x, q.y, q.z, q.w};
#pragma unroll
            for (int e = 0; e < 4; ++e) { v[8 * i + 2 * e] = bflo(qs[e]); v[8 * i + 2 * e + 1] = bfhi(qs[e]); sm += v[8 * i + 2 * e] * v[8 * i + 2 * e] + v[8 * i + 2 * e + 1] * v[8 * i + 2 * e + 1]; } }
        sm = wave_sum(sm);
        const float rstd = rsqrtf(sm * (1.0f / D) + EPS);
#pragma unroll
        for (int i = 0; i < 4; ++i) { const int c0 = (lane + 64 * i) * 8; const f32x4 w0 = *(const f32x4*)(w + c0), w1 = *(const f32x4*)(w + c0 + 4);
            f32x4 y0, y1;
#pragma unroll
            for (int j = 0; j < 4; ++j) { y0[j] = v[8 * i + j] * rstd * w0[j]; y1[j] = v[8 * i + 4 + j] * rstd * w1[j]; }
            *(f32x4*)(out + (size_t)row * D + c0) = y0; *(f32x4*)(out + (size_t)row * D + c0 + 4) = y1; }
    }
}
__device__ __forceinline__ void prep_phase(const float* X, bf16_t* hb, float* rs0) {
    int tq = threadIdx.x; asm volatile("" : "+v"(tq)); const int lane = tq & 63, gw = blockIdx.x * 8 + (tq >> 6), nw = gridDim.x * 8;
    for (int row = gw; row < T; row += nw) {
        const f32x4* xr = (const f32x4*)(X + (size_t)row * D); float sm = 0.f;
#pragma unroll
        for (int i = 0; i < 8; ++i) { const f32x4 v = xr[lane + 64 * i]; sm += v[0] * v[0] + v[1] * v[1] + v[2] * v[2] + v[3] * v[3];
            u32x2 p; p.x = cvt_pk_bf16(v[0], v[1]); p.y = cvt_pk_bf16(v[2], v[3]); ((u32x2*)(hb + (size_t)row * D))[lane + 64 * i] = p; }
        sm = wave_sum(sm);
        if (lane == 0) rs0[row] = rsqrtf(sm * (1.0f / D) + EPS);
    }
}
__device__ __forceinline__ void rsfinal_phase(const float* ssp, float* rs) {
    int tq = threadIdx.x; asm volatile("" : "+v"(tq));
    for (int row = blockIdx.x * NTHR + tq; row < T; row += gridDim.x * NTHR) { const f32x4* p = (const f32x4*)(ssp + (size_t)row * 32); float sm = 0.f;
#pragma unroll
        for (int i = 0; i < 8; ++i) { const f32x4 v = p[i]; sm += (v[0] + v[1]) + (v[2] + v[3]); }
        rs[row] = rsqrtf(sm * (1.0f / D) + EPS); }
}
__device__ __forceinline__ void rowrstd_phase(const float* X, float* rs) {
    int tq = threadIdx.x; asm volatile("" : "+v"(tq)); const int lane = tq & 63, gw = blockIdx.x * 8 + (tq >> 6), nw = gridDim.x * 8;
    for (int row = gw; row < T; row += nw) {
        const f32x4* xr = (const f32x4*)(X + (size_t)row * D); float ss = 0.f;
#pragma unroll
        for (int i = 0; i < 8; ++i) { const f32x4 v = xr[lane + 64 * i]; ss += v[0] * v[0] + v[1] * v[1] + v[2] * v[2] + v[3] * v[3]; }
        ss = wave_sum(ss);
        if (lane == 0) rs[row] = rsqrtf(ss * (1.0f / D) + EPS);
    }
}
__device__ __forceinline__ int src_col(int mode, int n, int Nsrc) {
    if (mode == 1) { const int pn = n >> 8, r = n & 255; return (r >> 7) * DFF + pn * 128 + (r & 127); }
    if (mode == 2) { if (n < 5120) return n; if (n < 13312) return n + 32; if (n < 13344) return n - 13312 + 5120; return -1; }
    if (mode == 3) return n < 16 ? 6144 + n : -1;
    return n < Nsrc ? n : -1;
}
__device__ __forceinline__ void convert_w(const float* W, int K, int Nsrc, bf16_t* Bt, int Ndst, int mode, unsigned char* lds, const float* nw = nullptr, int wk = -1, int nwk = 0, int lo16 = 0, int hi16 = 16) {
    if (wk < 0) { wk = blockIdx.x; nwk = gridDim.x; }
    int t = threadIdx.x; asm volatile("" : "+v"(t));
    const int lane = t & 63, nkt = K >> 6, ntiles = (Ndst >> 6) * nkt;
    const int tbeg = (int)((long)ntiles * lo16 / 16), tend = (int)((long)ntiles * hi16 / 16);
    for (int tl = tbeg + wk * 8 + (t >> 6); tl < tend; tl += nwk * 8) {
        const int n0 = (tl / nkt) << 6, k0 = (tl % nkt) << 6;
        const int sc = src_col(mode, n0 + lane, Nsrc);
        const float* src = W + (size_t)k0 * Nsrc + (sc >= 0 ? sc : 0);
        float v[64];
#pragma unroll
        for (int k = 0; k < 64; ++k) v[k] = src[(size_t)k * Nsrc];
        if (nw) {
#pragma unroll
            for (int k = 0; k < 64; ++k) v[k] *= nw[k0 + k]; }
        bf16_t* dst = Bt + (size_t)(n0 + lane) * K + k0;
#pragma unroll
        for (int q = 0; q < 8; ++q) { u32x4 w4;
            w4.x = cvt_pk_bf16(v[8 * q], v[8 * q + 1]); w4.y = cvt_pk_bf16(v[8 * q + 2], v[8 * q + 3]); w4.z = cvt_pk_bf16(v[8 * q + 4], v[8 * q + 5]); w4.w = cvt_pk_bf16(v[8 * q + 6], v[8 * q + 7]);
            if (sc < 0) w4 = (u32x4){0u, 0u, 0u, 0u};
            *(u32x4*)(dst + 8 * q) = w4; }
    }
}
__device__ __forceinline__ void convert_flat(const float* src, bf16_t* dst, int n) {
    int tq = threadIdx.x; asm volatile("" : "+v"(tq)); const int gt = blockIdx.x * NTHR + tq, ng = gridDim.x * NTHR;
    for (int i = gt; i < n / 4; i += ng) { const f32x4 v = ((const f32x4*)src)[i]; u32x2 p; p.x = cvt_pk_bf16(v[0], v[1]); p.y = cvt_pk_bf16(v[2], v[3]); ((u32x2*)dst)[i] = p; }
}
__device__ __forceinline__ void conv_phase(const bf16_t* PROJ, const float* cw, const float* cb, bf16_t* XC) {
    int tq = threadIdx.x; asm volatile("" : "+v"(tq)); const int gt = blockIdx.x * NTHR + tq, nseg = (int)(gridDim.x * NTHR) / 384;
    if (gt < nseg * 384) {
        const int c8 = (gt % 384) * 8, sg = gt / 384, len = (T + nseg - 1) / nseg, t0 = sg * len, t1 = min(T, t0 + len);
        float wk[4][8], bb[8];
#pragma unroll
        for (int e = 0; e < 8; ++e) { bb[e] = cb[c8 + e];
#pragma unroll
            for (int k = 0; k < 4; ++k) wk[k][e] = cw[k * 3072 + c8 + e]; }
        u32x4 h0 = {0u, 0u, 0u, 0u}, h1 = h0, h2 = h0;
        if (t0 >= 3 && t0 < T) { h0 = *(const u32x4*)(PROJ + (size_t)(t0 - 3) * NAB_BF + PXBC + c8); h1 = *(const u32x4*)(PROJ + (size_t)(t0 - 2) * NAB_BF + PXBC + c8); h2 = *(const u32x4*)(PROJ + (size_t)(t0 - 1) * NAB_BF + PXBC + c8); }
        for (int t = t0; t < t1; ++t) {
            const u32x4 h3 = *(const u32x4*)(PROJ + (size_t)t * NAB_BF + PXBC + c8);
            const u32x4 hs[4] = {h0, h1, h2, h3};
            float a[8];
#pragma unroll
            for (int e = 0; e < 8; ++e) a[e] = bb[e];
#pragma unroll
            for (int k = 0; k < 4; ++k) { const u32x4 xv = hs[k];
                a[0] += bflo(xv.x) * wk[k][0]; a[1] += bfhi(xv.x) * wk[k][1]; a[2] += bflo(xv.y) * wk[k][2]; a[3] += bfhi(xv.y) * wk[k][3];
                a[4] += bflo(xv.z) * wk[k][4]; a[5] += bfhi(xv.z) * wk[k][5]; a[6] += bflo(xv.w) * wk[k][6]; a[7] += bfhi(xv.w) * wk[k][7]; }
            u32x4 w; w.x = cvt_pk_bf16(siluf_(a[0]), siluf_(a[1])); w.y = cvt_pk_bf16(siluf_(a[2]), siluf_(a[3])); w.z = cvt_pk_bf16(siluf_(a[4]), siluf_(a[5])); w.w = cvt_pk_bf16(siluf_(a[6]), siluf_(a[7]));
            *(u32x4*)(XC + (size_t)t * 3072 + c8) = w;
            h0 = h1; h1 = h2; h2 = h3;
        }
    }
}

__device__ __forceinline__ bf16x8 frag(const bf16_t* X, int ld, int row0, int k0, int lane) { return *(const bf16x8*)(X + (row0 + (lane & 15)) * ld + k0 + (lane >> 4) * 8); }
#define MMA_T(acc, Aop, Bop) acc = __builtin_amdgcn_mfma_f32_16x16x32_bf16(Bop, Aop, acc, 0, 0, 0)

__device__ __forceinline__ void ssd_dtcum(const float* AUX, const float* dt_bias, const float* a_log, int c, int h, float* dts, float* cums) {
    int tq = threadIdx.x; asm volatile("" : "+v"(tq)); if (tq < 64) { const int l = tq;
        const float dt = softplusf_(AUX[(size_t)(c * 64 + l) * 256 + h] + dt_bias[h]);
        float s = dt * (-__expf(a_log[h]));
#pragma unroll
        for (int o = 1; o < 64; o <<= 1) { const float u = __shfl_up(s, o); if (l >= o) s += u; }
        dts[l] = dt; cums[l] = s; }
}

__device__ __forceinline__ void ssd_states(const bf16_t* XC, const float* AUX, const float* dt_bias, const float* a_log, bf16_t* STS, float* CDS, unsigned char* lds) {
    bf16_t* XWt = (bf16_t*)lds;
    bf16_t* Bt = (bf16_t*)(lds + 9216);
    float* dts = (float*)(lds + 9216 + 18432);
    float* cums = dts + 64;
    int t = threadIdx.x; asm volatile("" : "+v"(t));
    const int lane = t & 63, w = t >> 6;
    float dtraw = 0.f; u32x4 xv, bv[2];
#define SS_LOAD(IT) do { const int c_ = (IT) >> 5, h_ = (IT) & 31; \
        if (t < 64) dtraw = AUX[(size_t)(c_ * 64 + t) * 256 + h_]; \
        xv = *(const u32x4*)(XC + (size_t)(c_ * 64 + (t >> 3)) * 3072 + h_ * 64 + (t & 7) * 8); \
        _Pragma("unroll") for (int i = 0; i < 2; ++i) bv[i] = *(const u32x4*)(XC + (size_t)(c_ * 64 + (t >> 4) + 32 * i) * 3072 + 2048 + (h_ >> 3) * 128 + (t & 15) * 8); } while (0)
    int it = blockIdx.x;
    if (it < 128 * 32) SS_LOAD(it);
    for (; it < 128 * 32; it += gridDim.x) {
        const int c = it >> 5, h = it & 31;
        if (t < 64) { const float dt = softplusf_(dtraw + dt_bias[h]); float sc = dt * (-__expf(a_log[h]));
#pragma unroll
            for (int o = 1; o < 64; o <<= 1) { const float u = __shfl_up(sc, o); if (t >= o) sc += u; }
            dts[t] = dt; cums[t] = sc; }
        __syncthreads();
        { const int l = t >> 3, p8 = (t & 7) * 8; const float sc = dts[l] * __expf(cums[63] - cums[l]);
          const unsigned xs[4] = {xv.x, xv.y, xv.z, xv.w};
#pragma unroll
          for (int e = 0; e < 4; ++e) { XWt[(p8 + 2 * e) * 72 + l] = f2bf(bflo(xs[e]) * sc); XWt[(p8 + 2 * e + 1) * 72 + l] = f2bf(bfhi(xs[e]) * sc); } }
#pragma unroll
        for (int i = 0; i < 2; ++i) { const int l = (t >> 4) + 32 * i, n8 = (t & 15) * 8;
          const unsigned bs[4] = {bv[i].x, bv[i].y, bv[i].z, bv[i].w};
#pragma unroll
          for (int e = 0; e < 4; ++e) { Bt[(n8 + 2 * e) * 72 + l] = (bf16_t)(bs[e] & 0xffffu); Bt[(n8 + 2 * e + 1) * 72 + l] = (bf16_t)(bs[e] >> 16); } }
        if (t == 0) CDS[c * 32 + h] = __expf(cums[63]);
        if (it + (int)gridDim.x < 128 * 32) SS_LOAD(it + (int)gridDim.x);
        __syncthreads();
        { const int p0 = (w & 3) * 16; const bf16x8 a0 = frag(XWt, 72, p0, 0, lane), a1 = frag(XWt, 72, p0, 32, lane);
#pragma unroll
          for (int i = 0; i < 4; ++i) { const int n0 = ((w >> 2) * 4 + i) * 16; f32x4 acc = {0.f, 0.f, 0.f, 0.f};
            MMA_T(acc, a0, frag(Bt, 72, n0, 0, lane)); MMA_T(acc, a1, frag(Bt, 72, n0, 32, lane));
            u32x2 pk; pk.x = pack_bf16_sw(acc[0], acc[1]); pk.y = pack_bf16_sw(acc[2], acc[3]);
            *(u32x2*)(STS + ((size_t)(c * 32 + h) * 64 + p0 + (lane & 15)) * 128 + n0 + 4 * (lane >> 4)) = pk; } }
        __syncthreads();
    }
#undef SS_LOAD
}
__device__ __forceinline__ float hgrn_lb(const float* lg, int j) {
    const float a = lg[j], b = lg[2048 + j], c = lg[4096 + j], m = fmaxf(a, fmaxf(b, c));
    const float ea = __expf(a - m), eb = __expf(b - m), ec = __expf(c - m); return ea / (ea + eb + ec);
}
__device__ __forceinline__ void hgrn_states(const bf16_t* PROJ, const float* lbl, bf16_t* STH, float* CDH, unsigned char* lds) {
    bf16_t* KEt = (bf16_t*)lds;
    bf16_t* Vt = (bf16_t*)(lds + 18432);
    float* part = (float*)(lds + 36864);
    int t = threadIdx.x; asm volatile("" : "+v"(t));
    const int lane = t & 63, w = t >> 6, k = t & 127, lq = t >> 7;
    bf16_t fr[16]; u32x4 vv[2];
#define HS_LOAD(IT) do { const int c_ = (IT) >> 4, h_ = (IT) & 15; \
        _Pragma("unroll") for (int i = 0; i < 16; ++i) fr[i] = PROJ[(size_t)(c_ * 64 + lq * 16 + i) * NAB_BF + PF + h_ * 128 + k]; \
        _Pragma("unroll") for (int i = 0; i < 2; ++i) vv[i] = *(const u32x4*)(PROJ + (size_t)(c_ * 64 + (t >> 4) + 32 * i) * NAB_BF + PV_ + h_ * 128 + (t & 15) * 8); } while (0)
    int it = blockIdx.x;
    if (it < 128 * 16) HS_LOAD(it);
    for (; it < 128 * 16; it += gridDim.x) {
        const int c = it >> 4, h = it & 15;
        const float lb = hgrn_lb(lbl, h * 128 + k);
        float lf[16], kk[16], sm = 0.f;
#pragma unroll
        for (int i = 0; i < 16; ++i) { const float f = lb + (1.0f - lb) * sigmoidf_(bf2f(fr[i])); kk[i] = 1.0f - f; lf[i] = __logf(f); sm += lf[i]; }
        part[lq * 128 + k] = sm;
#pragma unroll
        for (int i = 0; i < 2; ++i) { const int l = (t >> 4) + 32 * i, v8 = (t & 15) * 8;
          const unsigned vs[4] = {vv[i].x, vv[i].y, vv[i].z, vv[i].w};
#pragma unroll
          for (int e = 0; e < 4; ++e) { Vt[(v8 + 2 * e) * 72 + l] = (bf16_t)(vs[e] & 0xffffu); Vt[(v8 + 2 * e + 1) * 72 + l] = (bf16_t)(vs[e] >> 16); } }
        __syncthreads();
        { float off = 0.f, tot = 0.f;
#pragma unroll
          for (int j = 0; j < 4; ++j) { const float pj = part[j * 128 + k]; tot += pj; if (j < lq) off += pj; }
          float run = off;
#pragma unroll
          for (int i = 0; i < 16; ++i) { run += lf[i]; KEt[k * 72 + lq * 16 + i] = f2bf(kk[i] * __expf(tot - run)); }
          if (lq == 0) CDH[(size_t)(c * 16 + h) * 128 + k] = __expf(tot); }
        if (it + (int)gridDim.x < 128 * 16) HS_LOAD(it + (int)gridDim.x);
        __syncthreads();
        { const int v0 = w * 16; const bf16x8 a0 = frag(Vt, 72, v0, 0, lane), a1 = frag(Vt, 72, v0, 32, lane);
#pragma unroll
          for (int i = 0; i < 8; ++i) { const int k0 = i * 16; f32x4 acc = {0.f, 0.f, 0.f, 0.f};
            MMA_T(acc, a0, frag(KEt, 72, k0, 0, lane)); MMA_T(acc, a1, frag(KEt, 72, k0, 32, lane));
            u32x2 pk; pk.x = pack_bf16_sw(acc[0], acc[1]); pk.y = pack_bf16_sw(acc[2], acc[3]);
            *(u32x2*)(STH + ((size_t)(c * 16 + h) * 128 + v0 + (lane & 15)) * 128 + k0 + 4 * (lane >> 4)) = pk; } }
        __syncthreads();
    }
#undef HS_LOAD
}
__device__ __forceinline__ void scan_phase(bf16_t* STS, const float* CDS, bf16_t* STH, const float* CDH) {
    int tq = threadIdx.x; asm volatile("" : "+v"(tq)); const int gt = blockIdx.x * NTHR + tq, ng = gridDim.x * NTHR;
    for (int e2 = gt; e2 < 131072; e2 += ng) {
        const int e = e2 * 2;
        const int hs = e >> 13, hh = e >> 14, k = e & 127;
        f32x2 cs = {0.f, 0.f}, ch = {0.f, 0.f};
#pragma unroll 1
        for (int cb = 0; cb < 128; cb += 8) {
            unsigned sv[8], gv[8]; f32x2 dh[8]; float ds[8];
#pragma unroll
            for (int i = 0; i < 8; ++i) { const int c = cb + i; sv[i] = *(const unsigned*)(STS + (size_t)c * 262144 + e); gv[i] = *(const unsigned*)(STH + (size_t)c * 262144 + e);
                ds[i] = CDS[c * 32 + hs]; dh[i] = *(const f32x2*)(CDH + (size_t)(c * 16 + hh) * 128 + k); }
#pragma unroll
            for (int i = 0; i < 8; ++i) { const int c = cb + i; *(unsigned*)(STS + (size_t)c * 262144 + e) = cvt_pk_bf16(cs[0], cs[1]); *(unsigned*)(STH + (size_t)c * 262144 + e) = cvt_pk_bf16(ch[0], ch[1]);
                cs = cs * ds[i] + (f32x2){bflo(sv[i]), bfhi(sv[i])}; ch = ch * dh[i] + (f32x2){bflo(gv[i]), bfhi(gv[i])}; }
        }
    }
}
__device__ __forceinline__ void ssd_out(const bf16_t* XC, const bf16_t* PROJ, const float* AUX, const float* dt_bias, const float* a_log, const float* dskip, const float* normw,
                                        const bf16_t* STS, bf16_t* Y, unsigned char* lds) {
    bf16_t* Cs = (bf16_t*)lds;
    bf16_t* Bs = (bf16_t*)(lds + 17408);
    float* CB = (float*)(lds + 34816);
    bf16_t* Wm = (bf16_t*)(lds + 51456);
    bf16_t* XDt = (bf16_t*)(lds + 60672);
    bf16_t* PVs = (bf16_t*)(lds + 69888);
    float* dts8 = (float*)(lds + 87296);
    float* cums8 = dts8 + 512;
    float* ss = cums8 + 512;
    int t = threadIdx.x; asm volatile("" : "+v"(t));
    const int lane = t & 63, w = t >> 6, r = lane & 15, q4 = lane >> 4;
    const int l0 = (w & 3) * 16, lrow = l0 + r;
    u32x4 xv; u32x4 pv[2]; u32x2 xe[2], ze[2];
#define SO_LOAD(C_, H_) do { xv = *(const u32x4*)(XC + (size_t)((C_) * 64 + (t >> 3)) * 3072 + (H_) * 64 + (t & 7) * 8); \
        _Pragma("unroll") for (int i = 0; i < 2; ++i) pv[i] = *(const u32x4*)(STS + ((size_t)((C_) * 32 + (H_)) * 64 + (t >> 4) + 32 * i) * 128 + (t & 15) * 8); \
        _Pragma("unroll") for (int i = 0; i < 2; ++i) { const int pc_ = (H_) * 64 + ((w >> 2) * 2 + i) * 16 + 4 * q4; \
            xe[i] = *(const u32x2*)(XC + (size_t)((C_) * 64 + lrow) * 3072 + pc_); ze[i] = *(const u32x2*)(PROJ + (size_t)((C_) * 64 + lrow) * NAB_BF + PZ + pc_); } } while (0)
    for (int it = blockIdx.x; it < 128 * 4; it += gridDim.x) {
        const int c = it >> 2, g = it & 3;
#pragma unroll
        for (int i = 0; i < 2; ++i) { const int l = (t >> 4) + 32 * i, n8 = (t & 15) * 8; const bf16_t* src = XC + (size_t)(c * 64 + l) * 3072 + 2048 + g * 128 + n8;
            *(u32x4*)(Bs + l * 136 + n8) = *(const u32x4*)src; *(u32x4*)(Cs + l * 136 + n8) = *(const u32x4*)(src + 512); }
        { const int h = g * 8 + w; const float dt = softplusf_(AUX[(size_t)(c * 64 + lane) * 256 + h] + dt_bias[h]); float sc = dt * (-__expf(a_log[h]));
#pragma unroll
          for (int o = 1; o < 64; o <<= 1) { const float u = __shfl_up(sc, o); if (lane >= o) sc += u; }
          dts8[w * 64 + lane] = dt; cums8[w * 64 + lane] = sc; }
        if (t < 64) ss[t] = 0.f;
        SO_LOAD(c, g * 8);
        __syncthreads();
        {
#pragma unroll
          for (int i = 0; i < 2; ++i) { const int s0 = ((w >> 2) * 2 + i) * 16; f32x4 acc = {0.f, 0.f, 0.f, 0.f};
#pragma unroll
            for (int ks = 0; ks < 4; ++ks) MMA_T(acc, frag(Cs, 136, l0, ks * 32, lane), frag(Bs, 136, s0, ks * 32, lane));
#pragma unroll
            for (int j = 0; j < 4; ++j) CB[(l0 + r) * 65 + s0 + 4 * q4 + j] = acc[j]; } }
        __syncthreads();
#pragma unroll 1
        for (int hh = 0; hh < 8; ++hh) {
            const int h = g * 8 + hh; const float* dts = dts8 + hh * 64; const float* cums = cums8 + hh * 64;
            { const int l = t >> 3, s8 = (t & 7) * 8; const float cl = cums[l]; float wv[8];
#pragma unroll
              for (int e = 0; e < 8; ++e) { const int sx = s8 + e; wv[e] = (l >= sx) ? CB[l * 65 + sx] * __expf(cl - cums[sx]) : 0.f; }
              u32x4 pk; pk.x = cvt_pk_bf16(wv[0], wv[1]); pk.y = cvt_pk_bf16(wv[2], wv[3]); pk.z = cvt_pk_bf16(wv[4], wv[5]); pk.w = cvt_pk_bf16(wv[6], wv[7]);
              *(u32x4*)(Wm + l * 72 + s8) = pk; }
            { const int sx = t >> 3, p8 = (t & 7) * 8; const float sc = dts[sx];
              const unsigned xs[4] = {xv.x, xv.y, xv.z, xv.w};
#pragma unroll
              for (int e = 0; e < 4; ++e) { XDt[(p8 + 2 * e) * 72 + sx] = f2bf(bflo(xs[e]) * sc); XDt[(p8 + 2 * e + 1) * 72 + sx] = f2bf(bfhi(xs[e]) * sc); } }
#pragma unroll
            for (int i = 0; i < 2; ++i) *(u32x4*)(PVs + ((t >> 4) + 32 * i) * 136 + (t & 15) * 8) = pv[i];
            u32x2 xc[2], zc[2];
#pragma unroll
            for (int i = 0; i < 2; ++i) { xc[i] = xe[i]; zc[i] = ze[i]; }
            if (hh < 7) SO_LOAD(c, h + 1);
            __syncthreads();
            { const float el = __expf(cums[lrow]), dsk = dskip[h]; const size_t tok = (size_t)(c * 64 + lrow);
              const bf16x8 w0 = frag(Wm, 72, l0, 0, lane), w1 = frag(Wm, 72, l0, 32, lane);
              bf16x8 cf[4];
#pragma unroll
              for (int ks = 0; ks < 4; ++ks) cf[ks] = frag(Cs, 136, l0, ks * 32, lane);
#pragma unroll
              for (int i = 0; i < 2; ++i) { const int p0 = ((w >> 2) * 2 + i) * 16; f32x4 ad = {0.f, 0.f, 0.f, 0.f}, ao = {0.f, 0.f, 0.f, 0.f};
                MMA_T(ad, w0, frag(XDt, 72, p0, 0, lane)); MMA_T(ad, w1, frag(XDt, 72, p0, 32, lane));
#pragma unroll
                for (int ks = 0; ks < 4; ++ks) MMA_T(ao, cf[ks], frag(PVs, 136, p0, ks * 32, lane));
                const int pc = h * 64 + p0 + 4 * q4;
                const float xf[4] = {bflo(xc[i].x), bfhi(xc[i].x), bflo(xc[i].y), bfhi(xc[i].y)}, zf[4] = {bflo(zc[i].x), bfhi(zc[i].x), bflo(zc[i].y), bfhi(zc[i].y)};
                float y[4], sq = 0.f;
#pragma unroll
                for (int j = 0; j < 4; ++j) { y[j] = (ad[j] + el * ao[j] + dsk * xf[j]) * siluf_(zf[j]); sq += y[j] * y[j]; }
                sq += __shfl_xor(sq, 16); sq += __shfl_xor(sq, 32);
                if (q4 == 0) atomicAdd(&ss[lrow], sq);
                u32x2 pk; pk.x = cvt_pk_bf16(y[0], y[1]); pk.y = cvt_pk_bf16(y[2], y[3]); *(u32x2*)(Y + tok * 4096 + pc) = pk; } }
            __syncthreads();
        }
        { const float rstd = rsqrtf(ss[lrow] * (1.0f / 512.0f) + EPS); const size_t tok = (size_t)(c * 64 + lrow);
          u32x2 yv[16];
#pragma unroll
          for (int q = 0; q < 16; ++q) yv[q] = *(const u32x2*)(Y + tok * 4096 + (g * 8 + (q >> 1)) * 64 + ((w >> 2) * 2 + (q & 1)) * 16 + 4 * q4);
#pragma unroll
          for (int q = 0; q < 16; ++q) { const int pc = (g * 8 + (q >> 1)) * 64 + ((w >> 2) * 2 + (q & 1)) * 16 + 4 * q4; const f32x4 nw = *(const f32x4*)(normw + pc);
              u32x2 pk; pk.x = cvt_pk_bf16(bflo(yv[q].x) * rstd * nw[0], bfhi(yv[q].x) * rstd * nw[1]); pk.y = cvt_pk_bf16(bflo(yv[q].y) * rstd * nw[2], bfhi(yv[q].y) * rstd * nw[3]);
              *(u32x2*)(Y + tok * 4096 + pc) = pk; } }
        __syncthreads();
    }
#undef SO_LOAD
}
__device__ __forceinline__ void hgrn_out(const bf16_t* PROJ, const float* lbl, const float* normw, const bf16_t* STH, bf16_t* Y, unsigned char* lds) {
    bf16_t* QR = (bf16_t*)lds;
    bf16_t* KR = (bf16_t*)(lds + 17408);
    bf16_t* QD = (bf16_t*)(lds + 34816);
    bf16_t* ATT = (bf16_t*)(lds + 52224);
    bf16_t* Vt = (bf16_t*)(lds + 61440);
    bf16_t* PT = (bf16_t*)(lds + 79872);
    float* part = (float*)(lds + 114688);
    float* ss = part + 512;
    int t = threadIdx.x; asm volatile("" : "+v"(t));
    const int lane = t & 63, w = t >> 6, r = lane & 15, q4 = lane >> 4, k = t & 127, lq = t >> 7;
    const int l0 = (w & 3) * 16, lrow = l0 + r;
    bf16_t fr[16], qr[16]; u32x4 vv[2]; u32x4 pt[4]; u32x2 gv[4];
#define HO_LOAD(IT) do { const int c_ = (IT) >> 4, h_ = (IT) & 15; \
        _Pragma("unroll") for (int i = 0; i < 16; ++i) { const bf16_t* p_ = PROJ + (size_t)(c_ * 64 + lq * 16 + i) * NAB_BF + h_ * 128 + k; fr[i] = p_[PF]; qr[i] = p_[PQ]; } \
        _Pragma("unroll") for (int i = 0; i < 2; ++i) vv[i] = *(const u32x4*)(PROJ + (size_t)(c_ * 64 + (t >> 4) + 32 * i) * NAB_BF + PV_ + h_ * 128 + (t & 15) * 8); \
        _Pragma("unroll") for (int i = 0; i < 4; ++i) pt[i] = *(const u32x4*)(STH + ((size_t)(c_ * 16 + h_) * 128 + (t >> 4) + 32 * i) * 128 + (t & 15) * 8); \
        _Pragma("unroll") for (int i = 0; i < 4; ++i) gv[i] = *(const u32x2*)(PROJ + (size_t)(c_ * 64 + lrow) * NAB_BF + PG + h_ * 128 + ((w >> 2) * 4 + i) * 16 + 4 * q4); } while (0)
    int it = blockIdx.x;
    if (it < 128 * 16) HO_LOAD(it);
    for (; it < 128 * 16; it += gridDim.x) {
        const int c = it >> 4, h = it & 15;
        const float lb = hgrn_lb(lbl, h * 128 + k);
        float lf[16], kk[16], qs[16], sm = 0.f;
#pragma unroll
        for (int i = 0; i < 16; ++i) { const float f = lb + (1.0f - lb) * sigmoidf_(bf2f(fr[i])); kk[i] = 1.0f - f; lf[i] = __logf(f); sm += lf[i]; qs[i] = siluf_(bf2f(qr[i])); }
        part[lq * 128 + k] = sm;
        if (t < 64) ss[t] = 0.f;
#pragma unroll
        for (int i = 0; i < 2; ++i) { const int l = (t >> 4) + 32 * i, v8 = (t & 15) * 8;
          const unsigned vs[4] = {vv[i].x, vv[i].y, vv[i].z, vv[i].w};
#pragma unroll
          for (int e = 0; e < 4; ++e) { Vt[(v8 + 2 * e) * 72 + l] = (bf16_t)(vs[e] & 0xffffu); Vt[(v8 + 2 * e + 1) * 72 + l] = (bf16_t)(vs[e] >> 16); } }
#pragma unroll
        for (int i = 0; i < 4; ++i) *(u32x4*)(PT + ((t >> 4) + 32 * i) * 136 + (t & 15) * 8) = pt[i];
        u32x2 gc[4];
#pragma unroll
        for (int i = 0; i < 4; ++i) gc[i] = gv[i];
        __syncthreads();
        { float off = 0.f;
#pragma unroll
          for (int j = 0; j < 4; ++j) { const float pj = part[j * 128 + k]; if (j < lq) off += pj; }
          const float mid = part[k] + part[128 + k];
          float run = off;
#pragma unroll
          for (int i = 0; i < 16; ++i) { run += lf[i]; const int l = lq * 16 + i;
            QR[l * 136 + k] = f2bf(qs[i] * __expf(run - mid)); KR[l * 136 + k] = f2bf(kk[i] * __expf(mid - run)); QD[l * 136 + k] = f2bf(qs[i] * __expf(run)); } }
        if (it + (int)gridDim.x < 128 * 16) HO_LOAD(it + (int)gridDim.x);
        __syncthreads();
        {
#pragma unroll
          for (int i = 0; i < 2; ++i) { const int s0 = ((w >> 2) * 2 + i) * 16; f32x4 acc = {0.f, 0.f, 0.f, 0.f};
#pragma unroll
            for (int ks = 0; ks < 4; ++ks) MMA_T(acc, frag(QR, 136, l0, ks * 32, lane), frag(KR, 136, s0, ks * 32, lane));
            const int sb = s0 + 4 * q4;
            u32x2 pk; pk.x = cvt_pk_bf16(lrow >= sb ? acc[0] : 0.f, lrow >= sb + 1 ? acc[1] : 0.f); pk.y = cvt_pk_bf16(lrow >= sb + 2 ? acc[2] : 0.f, lrow >= sb + 3 ? acc[3] : 0.f);
            *(u32x2*)(ATT + lrow * 72 + sb) = pk; } }
        __syncthreads();
        { const size_t tok = (size_t)(c * 64 + lrow);
          const bf16x8 a0 = frag(ATT, 72, l0, 0, lane), a1 = frag(ATT, 72, l0, 32, lane);
          bf16x8 qd[4];
#pragma unroll
          for (int ks = 0; ks < 4; ++ks) qd[ks] = frag(QD, 136, l0, ks * 32, lane);
          f32x4 acc[4]; float sq = 0.f;
#pragma unroll
          for (int i = 0; i < 4; ++i) { const int v0 = ((w >> 2) * 4 + i) * 16; acc[i] = (f32x4){0.f, 0.f, 0.f, 0.f};
            MMA_T(acc[i], a0, frag(Vt, 72, v0, 0, lane)); MMA_T(acc[i], a1, frag(Vt, 72, v0, 32, lane));
#pragma unroll
            for (int ks = 0; ks < 4; ++ks) MMA_T(acc[i], qd[ks], frag(PT, 136, v0, ks * 32, lane));
            sq += acc[i][0] * acc[i][0] + acc[i][1] * acc[i][1] + acc[i][2] * acc[i][2] + acc[i][3] * acc[i][3]; }
          sq += __shfl_xor(sq, 16); sq += __shfl_xor(sq, 32);
          if (q4 == 0) atomicAdd(&ss[lrow], sq);
          __syncthreads();
          const float rstd = rsqrtf(ss[lrow] * (1.0f / 128.0f) + EPS);
#pragma unroll
          for (int i = 0; i < 4; ++i) { const int vc = h * 128 + ((w >> 2) * 4 + i) * 16 + 4 * q4;
            const f32x4 nw = *(const f32x4*)(normw + vc);
            u32x2 pk; pk.x = cvt_pk_bf16(acc[i][0] * rstd * nw[0] * siluf_(bflo(gc[i].x)), acc[i][1] * rstd * nw[1] * siluf_(bfhi(gc[i].x)));
            pk.y = cvt_pk_bf16(acc[i][2] * rstd * nw[2] * siluf_(bflo(gc[i].y)), acc[i][3] * rstd * nw[3] * siluf_(bfhi(gc[i].y)));
            *(u32x2*)(Y + tok * 4096 + 2048 + vc) = pk; } }
        __syncthreads();
    }
#undef HO_LOAD
}
__device__ __forceinline__ void fraw_phase(const bf16_t* XN, const bf16_t* WF, const float* RS, float* FT) {
    int t = threadIdx.x; asm volatile("" : "+v"(t));
    const int lane = t & 63, w = t >> 6, r = lane & 15, q4 = lane >> 4;
    for (int rt = blockIdx.x * 8 + w; rt < T / 16; rt += gridDim.x * 8) {
        const bf16_t* ap = XN + (size_t)(rt * 16 + r) * D + q4 * 8; const bf16_t* bp = WF + (size_t)r * D + q4 * 8;
        f32x4 acc = {0.f, 0.f, 0.f, 0.f};
#pragma unroll 8
        for (int ks = 0; ks < D / 32; ++ks) { const bf16x8 a = *(const bf16x8*)(ap + ks * 32), b = *(const bf16x8*)(bp + ks * 32); MMA_T(acc, a, b); }
        const float rs = RS[rt * 16 + r];
#pragma unroll
        for (int j = 0; j < 4; ++j) FT[(size_t)(4 * q4 + j) * T + rt * 16 + r] = acc[j] * rs;
    }
}
__device__ __forceinline__ void dcum_block(const float* FT, const float* b_f, int hd, float* out, unsigned char* lds) {
    float* part = (float*)lds;
    int t = threadIdx.x; asm volatile("" : "+v"(t));
    float v[16], sm = 0.f; const float bf = b_f[hd];
    const f32x4* src = (const f32x4*)(FT + (size_t)hd * T + t * 16);
#pragma unroll
    for (int q = 0; q < 4; ++q) { const f32x4 x4 = src[q];
#pragma unroll
      for (int j = 0; j < 4; ++j) { const float x = x4[j] + bf; sm += fminf(x, 0.f) - log1pf(__expf(-fabsf(x))); v[4 * q + j] = sm; } }
    float incl = sm;
#pragma unroll
    for (int o = 1; o < 64; o <<= 1) { const float u = __shfl_up(incl, o); if ((t & 63) >= o) incl += u; }
    __syncthreads();
    if ((t & 63) == 63) part[t >> 6] = incl;
    __syncthreads();
    float off = incl - sm;
    for (int j = 0; j < (t >> 6); ++j) off += part[j];
#pragma unroll
    for (int q = 0; q < 4; ++q) { f32x4 o = {off + v[4 * q], off + v[4 * q + 1], off + v[4 * q + 2], off + v[4 * q + 3]}; *(f32x4*)(out + t * 16 + 4 * q) = o; }
    asm volatile("s_waitcnt vmcnt(0)" ::: "memory");
    __syncthreads();
}
__device__ __forceinline__ void vtrans_phase(const bf16_t* QKV, bf16_t* VT, float* KNT, unsigned char* lds) {
    bf16_t* Vt = (bf16_t*)lds;
    float* wm = (float*)(lds + 18432);
    int t = threadIdx.x; asm volatile("" : "+v"(t));
    for (int it = blockIdx.x; it < 16 * 128; it += gridDim.x) {
        const int hd = it & 15, k0 = (it >> 4) * 64;
        { const int key = t >> 3, d16 = (t & 7) * 16; const bf16_t* vp = QKV + (size_t)(k0 + key) * NFOX_BF + 4096 + hd * 128 + d16;
          const u32x4 va = *(const u32x4*)vp, vb = *(const u32x4*)(vp + 8), ka = *(const u32x4*)(vp - 2048), kb = *(const u32x4*)(vp - 2048 + 8);
          const int kq = key & 31, slot = (key & 32) + ((kq >> 2) & 3) * 8 + (kq >> 4) * 4 + (kq & 3);
          const unsigned vs[8] = {va.x, va.y, va.z, va.w, vb.x, vb.y, vb.z, vb.w}, ks[8] = {ka.x, ka.y, ka.z, ka.w, kb.x, kb.y, kb.z, kb.w};
          float sq = 0.f;
#pragma unroll
          for (int e = 0; e < 8; ++e) { Vt[(d16 + 2 * e) * 72 + slot] = (bf16_t)(vs[e] & 0xffffu); Vt[(d16 + 2 * e + 1) * 72 + slot] = (bf16_t)(vs[e] >> 16);
            const float a = bflo(ks[e]), b = bfhi(ks[e]); sq += a * a + b * b; }
          sq += __shfl_xor(sq, 1); sq += __shfl_xor(sq, 2); sq += __shfl_xor(sq, 4);
          sq = fmaxf(sq, __shfl_xor(sq, 8)); sq = fmaxf(sq, __shfl_xor(sq, 16)); sq = fmaxf(sq, __shfl_xor(sq, 32));
          if ((t & 63) == 0) wm[t >> 6] = sq; }
        __syncthreads();
#pragma unroll
        for (int i = 0; i < 2; ++i) { const int idx = t + 512 * i, d = idx >> 3, pc = (idx & 7) * 8;
          *(u32x4*)(VT + ((size_t)hd * 128 + d) * T + k0 + pc) = *(const u32x4*)(Vt + d * 72 + pc); }
        if (t == 0) { float mx = wm[0];
#pragma unroll
          for (int i = 1; i < 8; ++i) mx = fmaxf(mx, wm[i]);
          KNT[hd * 128 + (it >> 4)] = sqrtf(mx); }
        __syncthreads();
    }
}
__device__ __forceinline__ void fox_attn(const bf16_t* QKV, const bf16_t* VT, const float* FT, const float* b_f, float* DCP, const float* KNT, bf16_t* O, unsigned char* lds) {
    float* const DCUM = DCP + (size_t)blockIdx.x * T;
    int cur_hd = -1;
    bf16_t* Ks = (bf16_t*)lds;
    bf16_t* Vt = (bf16_t*)(lds + 34816);
    float* DK = (float*)(lds + 71680);
    unsigned* VOTE = (unsigned*)(lds + 72192);
    int t = threadIdx.x; asm volatile("" : "+v"(t));
    const int lane = t & 63, w = t >> 6, r = lane & 15, q4 = lane >> 4;
    const float LOG2E = 1.44269504088896f, SC2 = 0.08838834764831845f * LOG2E;
    for (int it = blockIdx.x; it < 512; it += gridDim.x) {
        const int rnd = it >> 8, b = it & 255, jj = b >> 4, hd = b & 15;
        const int qb = rnd == 0 ? 31 - jj : jj;
        const int q0 = qb * 256, rbase = q0 + w * 32;
        if (hd != cur_hd) { dcum_block(FT, b_f, hd, DCUM, lds); cur_hd = hd; }
        const int nkt = 4 * qb + 4;
        float kn = fmaxf(lane < nkt ? KNT[hd * 128 + lane] : 0.f, lane + 64 < nkt ? KNT[hd * 128 + 64 + lane] : 0.f);
#pragma unroll
        for (int o = 32; o >= 1; o >>= 1) kn = fmaxf(kn, __shfl_xor(kn, o));
        bf16x8 qf[2][4]; float dq[2], m[2], lsum[2], qnk[2]; f32x4 oacc[2][8];
#pragma unroll
        for (int g = 0; g < 2; ++g) { const int row = rbase + g * 16 + r; float sq = 0.f;
#pragma unroll
          for (int ks = 0; ks < 4; ++ks) { qf[g][ks] = *(const bf16x8*)(QKV + (size_t)row * NFOX_BF + hd * 128 + ks * 32 + q4 * 8);
#pragma unroll
            for (int e = 0; e < 8; ++e) { const float x = bf2f((bf16_t)qf[g][ks][e]); sq += x * x; } }
          sq += __shfl_xor(sq, 16); sq += __shfl_xor(sq, 32);
          qnk[g] = sqrtf(sq) * kn * SC2 * 1.001f + 1.0f;
          dq[g] = DCUM[row] * LOG2E; m[g] = -INFINITY; lsum[g] = 0.f;
#pragma unroll
          for (int i = 0; i < 8; ++i) oacc[g][i] = (f32x4){0.f, 0.f, 0.f, 0.f}; }
        const bf16_t* kptr = QKV + (size_t)(t >> 3) * NFOX_BF + 2048 + hd * 128 + (t & 7) * 16;
        const bf16_t* vptr = VT + ((size_t)hd * 128 + (t >> 2)) * T + (t & 3) * 16;
        const float* dptr = DCUM + (t & 63);
        const int kso = (t >> 3) * 136 + (t & 7) * 16, vso = (t >> 2) * 72 + (t & 3) * 16;
        u32x4 pk0, pk1, pv0, pv1; float pd;
        __syncthreads();
        { const int kl = (nkt - 1) * 64, cb = (nkt - 1) & 1; const bf16_t* kp = kptr + (size_t)kl * NFOX_BF; const bf16_t* vp = vptr + kl;
          pk0 = *(const u32x4*)kp; pk1 = *(const u32x4*)(kp + 8); pv0 = *(const u32x4*)vp; pv1 = *(const u32x4*)(vp + 8); pd = dptr[kl];
          *(u32x4*)(Ks + cb * 8704 + kso) = pk0; *(u32x4*)(Ks + cb * 8704 + kso + 8) = pk1; *(u32x4*)(Vt + cb * 9216 + vso) = pv0; *(u32x4*)(Vt + cb * 9216 + vso + 8) = pv1; if (t < 64) DK[cb * 64 + t] = pd * LOG2E; }
        __syncthreads();
        bool dead = false;
#pragma unroll 1
        for (int kt = nkt - 1; kt >= 0; --kt) {
            const int k0 = kt * 64, cur = kt & 1;
            const bool more = (kt > 0);
            float dnl = 0.f;
            if (more) { const bf16_t* kp = kptr + (size_t)(k0 - 64) * NFOX_BF; const bf16_t* vp = vptr + k0 - 64;
              pk0 = *(const u32x4*)kp; pk1 = *(const u32x4*)(kp + 8); pv0 = *(const u32x4*)vp; pv1 = *(const u32x4*)(vp + 8); pd = dptr[k0 - 64];
              dnl = DCUM[k0 - 1] * LOG2E; }
            if (k0 <= rbase + 31 && !dead) {
              const bf16_t* Kc = Ks + cur * 8704; const bf16_t* Vc = Vt + cur * 9216; const float* Dc = DK + cur * 64;
              f32x4 sc[2][4];
#pragma unroll
              for (int nt = 0; nt < 4; ++nt) { sc[0][nt] = (f32x4){0.f, 0.f, 0.f, 0.f}; sc[1][nt] = (f32x4){0.f, 0.f, 0.f, 0.f};
#pragma unroll
                for (int ks = 0; ks < 4; ++ks) { const bf16x8 kf = frag(Kc, 136, nt * 16, ks * 32, lane);
                  sc[0][nt] = __builtin_amdgcn_mfma_f32_16x16x32_bf16(kf, qf[0][ks], sc[0][nt], 0, 0, 0);
                  sc[1][nt] = __builtin_amdgcn_mfma_f32_16x16x32_bf16(kf, qf[1][ks], sc[1][nt], 0, 0, 0); } }
              f32x4 dk[4];
#pragma unroll
              for (int nt = 0; nt < 4; ++nt) dk[nt] = *(const f32x4*)(Dc + nt * 16 + 4 * q4);
              bf16x8 pf[2][2];
#pragma unroll
              for (int g = 0; g < 2; ++g) {
                const int row = rbase + g * 16 + r; const bool diag = (k0 + 63 > rbase + g * 16);
                float mx = -INFINITY;
#pragma unroll
                for (int nt = 0; nt < 4; ++nt)
#pragma unroll
                  for (int j = 0; j < 4; ++j) { float v = sc[g][nt][j] * SC2 + (dq[g] - dk[nt][j]); if (diag && (k0 + nt * 16 + 4 * q4 + j > row)) v = -INFINITY; sc[g][nt][j] = v; mx = fmaxf(mx, v); }
                mx = fmaxf(mx, __shfl_xor(mx, 16)); mx = fmaxf(mx, __shfl_xor(mx, 32));
                const float mn = fmaxf(m[g], mx), alpha = __builtin_amdgcn_exp2f(m[g] - mn); m[g] = mn;
                float ps = 0.f;
#pragma unroll
                for (int nt = 0; nt < 4; ++nt)
#pragma unroll
                  for (int j = 0; j < 4; ++j) { const float p = __builtin_amdgcn_exp2f(sc[g][nt][j] - mn); sc[g][nt][j] = p; ps += p; }
                lsum[g] = lsum[g] * alpha + ps;
#pragma unroll
                for (int i = 0; i < 8; ++i) oacc[g][i] *= alpha;
#pragma unroll
                for (int k2 = 0; k2 < 2; ++k2) { union { bf16x8 v; unsigned u[4]; } pp;
                  pp.u[0] = cvt_pk_bf16(sc[g][2 * k2][0], sc[g][2 * k2][1]); pp.u[1] = cvt_pk_bf16(sc[g][2 * k2][2], sc[g][2 * k2][3]);
                  pp.u[2] = cvt_pk_bf16(sc[g][2 * k2 + 1][0], sc[g][2 * k2 + 1][1]); pp.u[3] = cvt_pk_bf16(sc[g][2 * k2 + 1][2], sc[g][2 * k2 + 1][3]);
                  pf[g][k2] = pp.v; }
              }
#pragma unroll
              for (int k2 = 0; k2 < 2; ++k2)
#pragma unroll
                for (int i = 0; i < 8; ++i) { const bf16x8 vf = frag(Vc, 72, i * 16, k2 * 32, lane);
                  oacc[0][i] = __builtin_amdgcn_mfma_f32_16x16x32_bf16(vf, pf[0][k2], oacc[0][i], 0, 0, 0);
                  oacc[1][i] = __builtin_amdgcn_mfma_f32_16x16x32_bf16(vf, pf[1][k2], oacc[1][i], 0, 0, 0); }
            }
            if (more) { const int nb = cur ^ 1;
              const float ub = fmaxf(qnk[0] + (dq[0] - dnl) - m[0], qnk[1] + (dq[1] - dnl) - m[1]);
              dead = dead || (__ballot(!(ub < -160.0f)) == 0ull);
              *(u32x4*)(Ks + nb * 8704 + kso) = pk0; *(u32x4*)(Ks + nb * 8704 + kso + 8) = pk1; *(u32x4*)(Vt + nb * 9216 + vso) = pv0; *(u32x4*)(Vt + nb * 9216 + vso + 8) = pv1;
              if (t < 64) DK[nb * 64 + t] = pd * LOG2E;
              if (lane == 0) VOTE[cur * 8 + w] = dead ? 1u : 0u; }
            __syncthreads();
            if (more) { const u32x4 va = *(const u32x4*)(VOTE + cur * 8), vb = *(const u32x4*)(VOTE + cur * 8 + 4);
              if ((va.x & va.y & va.z & va.w & vb.x & vb.y & vb.z & vb.w) != 0u) break; }
        }
#pragma unroll
        for (int g = 0; g < 2; ++g) { const int row = rbase + g * 16 + r;
          float ls = lsum[g]; ls += __shfl_xor(ls, 16); ls += __shfl_xor(ls, 32);
          const float inv = 1.0f / ls;
#pragma unroll
          for (int i = 0; i < 8; ++i) { u32x2 pk; pk.x = cvt_pk_bf16(oacc[g][i][0] * inv, oacc[g][i][1] * inv); pk.y = cvt_pk_bf16(oacc[g][i][2] * inv, oacc[g][i][3] * inv);
            *(u32x2*)(O + (size_t)row * D + hd * 128 + i * 16 + 4 * q4) = pk; } }
    }
}

#define XB_TMO      128
#define XB_XCNT(j)  (256  + 64 * (j))
#define XB_XSUB(j)  (1280 + 64 * (j))
#define XB_XGEN(j)  (2304 + 64 * (j))
#define XB_TOP      3328
#define XB_TOPGEN   3392
#define XCD_BAR_WORDS 3456
#define XB_SPIN_CAP (1u << 20)
__device__ __forceinline__ unsigned xb_ld(unsigned* p)              { return __hip_atomic_load(p, __ATOMIC_RELAXED, __HIP_MEMORY_SCOPE_AGENT); }
__device__ __forceinline__ unsigned xb_add(unsigned* p, unsigned v) { return __hip_atomic_fetch_add(p, v, __ATOMIC_RELAXED, __HIP_MEMORY_SCOPE_AGENT); }
__device__ __forceinline__ unsigned xb_xcc_id() { return (unsigned)__builtin_amdgcn_s_getreg((3 << 11) | 20) & 0xFu; }
#define XB_SPIN(cond, bar) do { unsigned _sp = 0; while (cond) { __builtin_amdgcn_s_sleep(1); \
    if ((++_sp & 255u) == 0u) { if (xb_ld(&(bar)[XB_TMO])) break; if (_sp > XB_SPIN_CAP) { atomicAdd(&(bar)[XB_TMO], 1u); break; } } } } while (0)
struct XcdBarrier { unsigned* bar; unsigned x; volatile PG8_LAS unsigned* st; };
__device__ __forceinline__ XcdBarrier xcd_barrier_post(unsigned* bar, volatile PG8_LAS unsigned* st) {
    XcdBarrier b; b.bar = bar; b.x = xb_xcc_id(); b.st = st;
    if (threadIdx.x == 0) (void)xb_add(&bar[XB_XCNT(b.x)], 1u);
    return b;
}
__device__ __forceinline__ void xcd_barrier_complete(unsigned* bar, unsigned x, unsigned& nloc, unsigned& nx) {
    const unsigned G = gridDim.x * gridDim.y * gridDim.z;
    unsigned sum, cnt, mine, sp = 0u;
    for (;;) {
        sum = 0u; cnt = 0u; mine = 0u;
#pragma unroll
        for (unsigned j = 0; j < 16; ++j) { const unsigned c = xb_ld(&bar[XB_XCNT(j)]); sum += c; cnt += (c > 0u) ? 1u : 0u; mine = (j == x) ? c : mine; }
        if (sum == G) break;
        __builtin_amdgcn_s_sleep(1);
        if ((++sp & 255u) == 0u) { if (xb_ld(&bar[XB_TMO])) break; if (sp > XB_SPIN_CAP) { atomicAdd(&bar[XB_TMO], 1u); break; } }
    }
    nloc = mine > 0u ? mine : 1u; nx = cnt > 0u ? cnt : 1u;
}
__device__ __forceinline__ void xcd_barrier(const XcdBarrier& b) {
    asm volatile("s_waitcnt vmcnt(0)" ::: "memory");
    __syncthreads();
    if (threadIdx.x == 0) {
        unsigned* bar = b.bar;
        __builtin_amdgcn_s_waitcnt(0);
        unsigned nloc = b.st[0], nx = b.st[1];
        if (nloc == 0u) { xcd_barrier_complete(bar, b.x, nloc, nx); b.st[0] = nloc; b.st[1] = nx; }
        const unsigned old = xb_add(&bar[XB_XSUB(b.x)], 1u);
        const unsigned gen = old / nloc;
        if (old + 1u == (gen + 1u) * nloc) {
            __builtin_amdgcn_fence(__ATOMIC_RELEASE, "agent");
            asm volatile("s_waitcnt vmcnt(0)" ::: "memory");
            const unsigned og = xb_add(&bar[XB_TOP], 1u);
            const unsigned tg = og / nx;
            if (og + 1u == (tg + 1u) * nx) xb_add(&bar[XB_TOPGEN], 1u);
            else XB_SPIN(xb_ld(&bar[XB_TOPGEN]) == tg, bar);
            __builtin_amdgcn_fence(__ATOMIC_ACQUIRE, "agent");
            xb_add(&bar[XB_XGEN(b.x)], 1u);
            asm volatile("s_waitcnt vmcnt(0)" ::: "memory");
        } else {
            XB_SPIN(xb_ld(&bar[XB_XGEN(b.x)]) == gen, bar);
            __builtin_amdgcn_fence(__ATOMIC_ACQUIRE, "agent");
            asm volatile("s_waitcnt vmcnt(0)" ::: "memory");
        }
    }
    __syncthreads();
}

template <class Epi>
__device__ __forceinline__ void run_gemm(unsigned char* lds, const bf16_t* A, const bf16_t* Bt, int N, int K, const Epi& E) {
    int Mv = T, Nv = N, Kv = K; asm volatile("" : "+s"(Mv), "+s"(Nv), "+s"(Kv)); Gemm g{A, Bt, Mv, Nv, Kv}; StaticOrder S; S.init(Mv, Nv, (int)gridDim.x, (int)blockIdx.x);
    gemm_phase<Epi, StaticOrder, false>((PG8_LAS unsigned char*)lds, g, S, E, nullptr);
}
__device__ __forceinline__ bool tail_worker(int nunits, int& wk, int& nwk) {
    const int G = gridDim.x, extra = nunits % G, c = blockIdx.x;
    if (extra == 0) { wk = c; nwk = G; return true; }
    if (c >= extra) { wk = c - extra; nwk = G - extra; return true; }
    return false;
}
__device__ __forceinline__ void rs_prestep(const float* ssp, float* rs, int N) {
    StaticOrder S; S.init(T, N, (int)gridDim.x, (int)blockIdx.x);
    int tq = threadIdx.x; asm volatile("" : "+v"(tq));
    unsigned donemask = 0u; Unit u;
    for (int i = 0; S.next(i, u); ++i) {
        if (donemask & (1u << u.pm)) continue;
        donemask |= (1u << u.pm);
        if (tq < 256) { const int row = u.pm * 256 + tq; const f32x4* p = (const f32x4*)(ssp + (size_t)row * 32); float sm = 0.f;
#pragma unroll
            for (int q = 0; q < 8; ++q) { const f32x4 v = p[q]; sm += (v[0] + v[1]) + (v[2] + v[3]); }
            rs[row] = rsqrtf(sm * (1.0f / D) + EPS); }
    }
    asm volatile("s_waitcnt vmcnt(0)" ::: "memory");
    __syncthreads();
}
__device__ __forceinline__ void convert_half(int par, const float* W, int K, int Nsrc, bf16_t* Bt, int Ndst, int mode, unsigned char* lds, const float* nw) {
    if (gridDim.x & 1) { if (par == 0) convert_w(W, K, Nsrc, Bt, Ndst, mode, lds, nw); return; }
    if ((int)(blockIdx.x & 1) != par) return;
    convert_w(W, K, Nsrc, Bt, Ndst, mode, lds, nw, (int)(blockIdx.x >> 1), (int)(gridDim.x >> 1), par * 8, par * 8 + 8);
}
constexpr int NPHASES = 22;
__global__ void __launch_bounds__(NTHR) mega(Params P) {
    extern __shared__ __attribute__((aligned(16))) unsigned char lds[];
    cg::grid_group grid = cg::this_grid();
    unsigned char* ws = P.ws;
    float* H = (float*)(ws + OFF_H); bf16_t* XN = (bf16_t*)(ws + OFF_XN); bf16_t* WB0 = (bf16_t*)(ws + OFF_WB0); bf16_t* WB1 = (bf16_t*)(ws + OFF_WB1); bf16_t* WB2 = (bf16_t*)(ws + OFF_WB2); bf16_t* HB2 = (bf16_t*)(ws + OFF_HB2); float* RS = (float*)(ws + OFF_RS); float* SSP = (float*)(ws + OFF_SSP); float* SSPE = (float*)(ws + OFF_SSPE); float* SSPB = (float*)(ws + OFF_SSPB); bf16_t* WBX = (bf16_t*)(ws + OFF_H);
    bf16_t* ACT = (bf16_t*)(ws + OFF_ACT);
    bf16_t* PROJ = (bf16_t*)(ws + OFF_PROJ); float* AUX = (float*)(ws + OFF_AUX); bf16_t* XC = (bf16_t*)(ws + OFF_XC);
    bf16_t* STS = (bf16_t*)(ws + OFF_STS); bf16_t* STH = (bf16_t*)(ws + OFF_STH); bf16_t* Y = (bf16_t*)(ws + OFF_Y); float* CDS = (float*)(ws + OFF_CDS); float* CDH = (float*)(ws + OFF_CDH);
    bf16_t* QKV = (bf16_t*)(ws + OFF_QKV); float* FAUX = (float*)(ws + OFF_FAUX); float* DCUM = (float*)(ws + OFF_DCUM); bf16_t* OB = (bf16_t*)(ws + OFF_O); bf16_t* VTB = (bf16_t*)(ws + OFF_VT); float* KNT = (float*)(ws + OFF_KNT);
    bf16_t* PB = (bf16_t*)(ws + OFF_PB); bf16_t* EB = (bf16_t*)(ws + OFF_E); float* RSTD = (float*)(ws + OFF_RSTD);
    volatile PG8_LAS unsigned* bst = (volatile PG8_LAS unsigned*)((PG8_LAS unsigned char*)lds + 131072);
    if (threadIdx.x < 4) bst[threadIdx.x] = 0u;
    __syncthreads();
    XcdBarrier xbar = xcd_barrier_post((unsigned*)(ws + OFF_BAR), bst);
    int ph = 0;
#define PHASE_BEGIN if (ph >= P.ph_lo && ph < P.ph_hi) { if (ph > P.ph_lo) { if (P.ph_hi < 0) grid.sync(); else xcd_barrier(xbar); }
#define PHASE_END } ++ph;
    PHASE_BEGIN
        prep_phase(P.in[0], HB2, RS);
        convert_w(P.in[3], D, NFF, WB0, NFF, 1, lds, P.in[2]);
    PHASE_END
#pragma unroll 1
    for (int L = 0; L < 2; ++L) {
#pragma unroll 1
        for (int f = 0; f < 2; ++f) {
            if (f == 1) {
                if (L == 0) {
                    PHASE_BEGIN { rs_prestep(SSP, RS, NAB); EpiProj E{PROJ, NAB_BF, NAB_BF / 256, AUX, RS}; run_gemm(lds, XN, WB0, NAB, D, E); int wk, nwk; if (tail_worker(32 * (NAB / 256), wk, nwk)) convert_w(P.in[15], 4096, D, WB1, D, 0, lds, nullptr, wk, nwk); } PHASE_END
                    PHASE_BEGIN conv_phase(PROJ, P.in[7], P.in[8], XC); PHASE_END
                    PHASE_BEGIN ssd_states(XC, AUX, P.in[9], P.in[10], STS, CDS, lds); hgrn_states(PROJ, P.in[13], STH, CDH, lds); PHASE_END
                    PHASE_BEGIN scan_phase(STS, CDS, STH, CDH); PHASE_END
                    PHASE_BEGIN ssd_out(XC, PROJ, AUX, P.in[9], P.in[10], P.in[11], P.in[12], STS, Y, lds); hgrn_out(PROJ, P.in[13], P.in[14], STH, Y, lds); PHASE_END
                } else {
                    PHASE_BEGIN { rs_prestep(SSP, RS, NFOX); EpiProj E{QKV, NFOX_BF, NFOX_BF / 256, FAUX, RS}; run_gemm(lds, XN, WB0, NFOX, D, E); int wk, nwk; if (tail_worker(32 * (NFOX / 256), wk, nwk)) convert_w(P.in[18], D, D, WB1, D, 0, lds, nullptr, wk, nwk); } PHASE_END
                    PHASE_BEGIN fraw_phase(XN, WB2, RS, FAUX); vtrans_phase(QKV, VTB, KNT, lds); PHASE_END
                    PHASE_BEGIN fox_attn(QKV, VTB, FAUX, P.in[17], DCUM, KNT, OB, lds); PHASE_END
                }
                PHASE_BEGIN
                    convert_half(1, P.in[20] + (size_t)L * D * NFF, D, NFF, WB0, NFF, 1, lds, P.in[19] + L * D);
                    if (L == 0) { EpiResid E{XN, XN, D, 1.0f, SSP}; run_gemm(lds, Y, WB1, D, 4096, E); }
                    else { EpiResid E{XN, XN, D, 1.0f, SSP}; run_gemm(lds, OB, WB1, D, D, E); }
                    __syncthreads();
                    convert_half(0, P.in[20] + (size_t)L * D * NFF, D, NFF, WB0, NFF, 1, lds, P.in[19] + L * D);
                    convert_w(P.in[24] + (size_t)L * 256 * D, 256, D, WB2, D, 0, lds); convert_flat(P.in[1] + (size_t)L * T * 256, PB, T * 256);
                PHASE_END
            }
            const int bi = f == 0 ? 2 : 19;
            PHASE_BEGIN { if (f == 1 || L == 1) rs_prestep(f == 0 ? SSPB : SSP, RS, NFF);
                EpiSwiGLU E{ACT, DFF, RS}; run_gemm(lds, f == 0 ? HB2 : XN, (f == 0 && L == 1) ? WBX : WB0, NFF, D, E);
                int wk, nwk; if (tail_worker(32 * (NFF / 256), wk, nwk)) convert_w(P.in[bi + 2] + (size_t)L * DFF * D, DFF, D, WB1, D, 0, lds, nullptr, wk, nwk); } PHASE_END
            PHASE_BEGIN
                if (f == 0) { if (L == 0) convert_half(1, P.in[6], D, 13344, WB0, NAB, 2, lds, P.in[5]); else convert_half(1, P.in[16], D, 6160, WB0, NFOX, 0, lds, P.in[5] + D); }
                { EpiResid E{f == 0 ? HB2 : XN, XN, D, 0.5f, SSP}; run_gemm(lds, ACT, WB1, D, DFF, E); }
                __syncthreads();
                if (f == 0) {
                    if (L == 0) convert_half(0, P.in[6], D, 13344, WB0, NAB, 2, lds, P.in[5]);
                    else { convert_half(0, P.in[16], D, 6160, WB0, NFOX, 0, lds, P.in[5] + D); convert_w(P.in[16], D, 6160, WB2, 64, 3, lds, P.in[5] + D); }
                } else {
                    EpiStoreE E2{EB, D, SSPE}; run_gemm(lds, PB, WB2, D, 256, E2);
                    __syncthreads();
                    convert_w(P.in[23] + (size_t)L * D * D, D, D, WB0, D, 0, lds, P.in[22] + L * D);
                }
            PHASE_END
        }
        PHASE_BEGIN
            if (L == 0) convert_half(1, P.in[3] + (size_t)D * NFF, D, NFF, WBX, NFF, 1, lds, P.in[2] + D);
            { rs_prestep(SSP, RS, D); rs_prestep(SSPE, RSTD, D);
            EpiPle E{EB, RSTD, P.in[25] + L * D, XN, D, RS, HB2, SSPB}; run_gemm(lds, XN, WB0, D, D, E); }
            if (L == 0) { __syncthreads(); convert_half(0, P.in[3] + (size_t)D * NFF, D, NFF, WBX, NFF, 1, lds, P.in[2] + D); }
        PHASE_END
    }
    PHASE_BEGIN finalnorm_phase(HB2, P.in[26], P.out); PHASE_END
}

extern "C" void kernel_launch(void* const* d_in, const int* in_sizes, int n_in, void* d_out, int out_size, void* d_ws, size_t ws_size, hipStream_t stream) {
    static int grid = 0;
    if (grid == 0) {
        if (n_in != 27 || ws_size < WS_END) { fprintf(stderr, "kernel_launch: need 27 inputs and %zu bytes of workspace (got %d, %zu)\n", (size_t)WS_END, n_in, ws_size); grid = -1; return; }
        int dev = 0, cus = 0, per_cu = 0;
        (void)hipGetDevice(&dev); (void)hipDeviceGetAttribute(&cus, hipDeviceAttributeMultiprocessorCount, dev);
        if (hipFuncSetAttribute((const void*)mega, hipFuncAttributeMaxDynamicSharedMemorySize, LDS_BYTES) != hipSuccess) { fprintf(stderr, "kernel_launch: hipFuncSetAttribute failed\n"); grid = -1; return; }
        if (hipOccupancyMaxActiveBlocksPerMultiprocessor(&per_cu, (const void*)mega, NTHR, LDS_BYTES) != hipSuccess || per_cu < 1) { fprintf(stderr, "kernel_launch: occupancy query says %d\n", per_cu); per_cu = 1; }
        (void)hipGetLastError();
        grid = cus * 1;
    }
    if (grid < 0) return;
    if (hipMemsetAsync((char*)d_ws + OFF_BAR, 0, 16384, stream) != hipSuccess) { fprintf(stderr, "kernel_launch: memset failed\n"); return; }
    Params p{};
    for (int i = 0; i < 27; ++i) p.in[i] = (const float*)d_in[i];
    p.out = (float*)d_out; p.ws = (unsigned char*)d_ws;
#if ONE_LAUNCH
    p.ph_lo = 0; p.ph_hi = NPHASES;
    void* args[] = {&p};
    hipError_t e = hipLaunchCooperativeKernel((const void*)mega, dim3(grid), dim3(NTHR), args, LDS_BYTES, stream);
    if (e != hipSuccess) fprintf(stderr, "cooperative launch failed: %s (grid %d)\n", hipGetErrorString(e), grid);
#else
    for (int ph = 0; ph < NPHASES; ++ph) { p.ph_lo = ph; p.ph_hi = ph + 1; hipLaunchKernelGGL(mega, dim3(grid), dim3(NTHR), LDS_BYTES, stream, p); }
#endif
}
```

```cpp
#include <hip/hip_runtime.h>
#include <hip/hip_cooperative_groups.h>
#include <cstdio>
namespace cg = cooperative_groups;
#ifndef ONE_LAUNCH
#define ONE_LAUNCH 1
#endif
namespace pg8 {
#define PG8_LAS __attribute__((address_space(3)))
typedef unsigned short bf16_t;
typedef short bf16x8 __attribute__((ext_vector_type(8)));
typedef float f32x4 __attribute__((ext_vector_type(4)));
typedef unsigned u32x4 __attribute__((ext_vector_type(4)));
constexpr int BM = 256, BK = 64, HALF = 128, HTB = HALF * BK * 2  , STAGE_BYTES = 8 * HTB, NXCD = 8, WGM = 4;

__host__ __device__ __forceinline__ int lds_byte(int r, int c) { const int st = (r >> 4) * 2 + (c >> 5), rr = r & 15, cc = c & 31, ob = rr * 64 + cc * 2; return st * 1024 + (ob ^ (((ob >> 9) & 1) << 5)); }
__host__ __device__ __forceinline__ void stage_rc(int b, int& R, int& C) { const int st = b / 1024, sb = b % 1024, swz = sb ^ (((sb >> 9) & 1) << 5); R = (st >> 1) * 16 + swz / 64; C = (st & 1) * 32 + (swz % 64) / 2; }
__host__ __device__ __forceinline__ int perm32(int rho) { const int n = rho >> 4, i = rho & 15; return 8 * (i >> 2) + 4 * n + (i & 3); }

struct Unit { int pm, pn; };
struct Gemm { const bf16_t* A; const bf16_t* Bt; int M, N, K; };

struct StaticOrder {
    int nM, nN, nwg, G, c;
    __host__ __device__ void init(int M, int N, int G_, int c_) { nM = M / BM; nN = N / BM; nwg = nM * nN; G = G_; c = c_; }
    __host__ __device__ bool next(int i, Unit& u) const {
        const long L = (long)i * G + c; if (L >= nwg) return false;
        int wgid = (int)L; { const int q = nwg / NXCD, r = nwg % NXCD, xcd = wgid % NXCD, off = wgid / NXCD; wgid = (xcd < r ? xcd * (q + 1) : r * (q + 1) + (xcd - r) * q) + off; }
        const int nig = WGM * nN, gid = wgid / nig, fm = gid * WGM, gsz = (nM - fm) < WGM ? (nM - fm) : WGM;
        u.pm = fm + ((wgid % nig) % gsz); u.pn = (wgid % nig) / gsz; return true;
    }
    __device__ __forceinline__ void a_ready(const Unit&) const {}
    __device__ __forceinline__ void done(const Unit&) const {}
};
typedef unsigned u32x2 __attribute__((ext_vector_type(2)));
typedef float f32x2 __attribute__((ext_vector_type(2)));
typedef __bf16 bf16x2_cv __attribute__((ext_vector_type(2)));
typedef float f32x2_cv __attribute__((ext_vector_type(2)));
__device__ __forceinline__ unsigned cvt_pk_bf16(float lo, float hi) { const f32x2_cv v = {lo, hi}; return __builtin_bit_cast(unsigned, __builtin_convertvector(v, bf16x2_cv)); }
__device__ __forceinline__ unsigned pack_bf16_sw(float lo, float hi) { return cvt_pk_bf16(lo, hi); }
__device__ __forceinline__ bf16_t f2bf(float x) { return (bf16_t)(cvt_pk_bf16(x, 0.f) & 0xffffu); }
__device__ __forceinline__ float bf2f(bf16_t b) { return __uint_as_float(((unsigned)b) << 16); }
__device__ __forceinline__ float bflo(unsigned w) { return __uint_as_float(w << 16); }
__device__ __forceinline__ float bfhi(unsigned w) { return __uint_as_float(w & 0xffff0000u); }
__device__ __forceinline__ float sigmoidf_(float x) { return __builtin_amdgcn_rcpf(1.0f + __expf(-x)); }
__device__ __forceinline__ float siluf_(float x) { return x * sigmoidf_(x); }
__device__ __forceinline__ float softplusf_(float x) { return fmaxf(x, 0.f) + log1pf(__expf(-fabsf(x))); }

__device__ __forceinline__ void load_rows8(float (&rsv)[8], const float* p0, const float* p1) {
    asm volatile("global_load_dword %0, %8, off\n\tglobal_load_dword %1, %8, off offset:64\n\tglobal_load_dword %2, %8, off offset:128\n\tglobal_load_dword %3, %8, off offset:192\n\t"
                 "global_load_dword %4, %9, off\n\tglobal_load_dword %5, %9, off offset:64\n\tglobal_load_dword %6, %9, off offset:128\n\tglobal_load_dword %7, %9, off offset:192\n\t"
                 "s_waitcnt vmcnt(0)"
                 : "=&v"(rsv[0]), "=&v"(rsv[1]), "=&v"(rsv[2]), "=&v"(rsv[3]), "=&v"(rsv[4]), "=&v"(rsv[5]), "=&v"(rsv[6]), "=&v"(rsv[7]) : "v"(p0), "v"(p1) : "memory");
}
struct EpiSwiGLU {
    static constexpr bool PERM = true, AFTER_DRAIN = false;
    bf16_t* O; int ldc; const float* rsr;
    __device__ __forceinline__ void operator()(const f32x4 (&acc)[2][2][4][2], const Unit& u, int wr, int wc, int fr, int fq) const {
        const int row0 = u.pm * BM + wr * 64 + fr, col0 = u.pn * 128 + wc * 32 + 8 * fq;
        float rsv[8]; load_rows8(rsv, rsr + row0, rsr + row0 + HALF);
#pragma unroll
        for (int ai = 0; ai < 2; ++ai)
#pragma unroll
            for (int m = 0; m < 4; ++m) {
                bf16_t* rowp = O + (size_t)(row0 + ai * HALF + m * 16) * ldc + col0;
                f32x4 v0, v1; const float rs = rsv[ai * 4 + m];
#pragma unroll
                for (int j = 0; j < 4; ++j) { v0[j] = siluf_(acc[ai][0][m][0][j] * rs) * (acc[ai][1][m][0][j] * rs); v1[j] = siluf_(acc[ai][0][m][1][j] * rs) * (acc[ai][1][m][1][j] * rs); }
                u32x4 w; w.x = cvt_pk_bf16(v0[0], v0[1]); w.y = cvt_pk_bf16(v0[2], v0[3]); w.z = cvt_pk_bf16(v1[0], v1[1]); w.w = cvt_pk_bf16(v1[2], v1[3]);
                *(u32x4*)rowp = w;
            }
    }
};
struct EpiResid {
    static constexpr bool PERM = true, AFTER_DRAIN = false;
    const bf16_t* hin; bf16_t* hout; int ldc; float alpha; float* ssp;
    __device__ __forceinline__ void operator()(const f32x4 (&acc)[2][2][4][2], const Unit& u, int wr, int wc, int fr, int fq) const {
        const int row0 = u.pm * BM + wr * 64 + fr, col0 = u.pn * BM + wc * 32 + 8 * fq;
        u32x4 b[8][2];
#pragma unroll
        for (int g = 0; g < 8; ++g) { const size_t off = (size_t)(row0 + (g >> 2) * HALF + (g & 3) * 16) * ldc + col0; b[g][0] = *(const u32x4*)(hin + off); b[g][1] = *(const u32x4*)(hin + off + HALF); }
#pragma unroll
        for (int g = 0; g < 8; ++g) { const int ai = g >> 2, m = g & 3, row = row0 + ai * HALF + m * 16; const size_t off = (size_t)row * ldc + col0;
            float sq = 0.f;
#pragma unroll
            for (int bj = 0; bj < 2; ++bj) { const u32x4 bv = b[g][bj]; const f32x4 a0 = acc[ai][bj][m][0], a1 = acc[ai][bj][m][1];
                const float r0 = bflo(bv.x) + alpha * a0[0], r1 = bfhi(bv.x) + alpha * a0[1], r2 = bflo(bv.y) + alpha * a0[2], r3 = bfhi(bv.y) + alpha * a0[3];
                const float r4 = bflo(bv.z) + alpha * a1[0], r5 = bfhi(bv.z) + alpha * a1[1], r6 = bflo(bv.w) + alpha * a1[2], r7 = bfhi(bv.w) + alpha * a1[3];
                sq += (r0 * r0 + r1 * r1) + (r2 * r2 + r3 * r3) + (r4 * r4 + r5 * r5) + (r6 * r6 + r7 * r7);
                u32x4 pk; pk.x = cvt_pk_bf16(r0, r1); pk.y = cvt_pk_bf16(r2, r3); pk.z = cvt_pk_bf16(r4, r5); pk.w = cvt_pk_bf16(r6, r7);
                *(u32x4*)(hout + off + bj * HALF) = pk; }
            sq += __shfl_xor(sq, 16); sq += __shfl_xor(sq, 32);
            if (fq == 0) ssp[(size_t)row * 32 + u.pn * 4 + wc] = sq; }
    }
};
struct EpiProj {
    static constexpr bool PERM = true, AFTER_DRAIN = false;
    bf16_t* O; int ldc; int n_bf; float* aux; const float* rsr;
    __device__ __forceinline__ void operator()(const f32x4 (&acc)[2][2][4][2], const Unit& u, int wr, int wc, int fr, int fq) const {
        const int row0 = u.pm * BM + wr * 64 + fr;
        float rsv[8]; load_rows8(rsv, rsr + row0, rsr + row0 + HALF);
        if (u.pn < n_bf) {
            const int col0 = u.pn * BM + wc * 32 + 8 * fq;
#pragma unroll
            for (int ai = 0; ai < 2; ++ai)
#pragma unroll
                for (int m = 0; m < 4; ++m) { bf16_t* rowp = O + (size_t)(row0 + ai * HALF + m * 16) * ldc + col0;
#pragma unroll
                    for (int bj = 0; bj < 2; ++bj) { const f32x4 v0 = acc[ai][bj][m][0] * rsv[ai * 4 + m], v1 = acc[ai][bj][m][1] * rsv[ai * 4 + m];
                        u32x4 w; w.x = cvt_pk_bf16(v0[0], v0[1]); w.y = cvt_pk_bf16(v0[2], v0[3]); w.z = cvt_pk_bf16(v1[0], v1[1]); w.w = cvt_pk_bf16(v1[2], v1[3]);
                        *(u32x4*)(rowp + bj * HALF) = w; } }
        } else {
            const int col0 = wc * 32 + 8 * fq;
#pragma unroll
            for (int ai = 0; ai < 2; ++ai)
#pragma unroll
                for (int m = 0; m < 4; ++m) { float* rowp = aux + (size_t)(row0 + ai * HALF + m * 16) * 256 + col0;
#pragma unroll
                    for (int bj = 0; bj < 2; ++bj)
#pragma unroll
                        for (int n = 0; n < 2; ++n) *(f32x4*)(rowp + bj * HALF + 4 * n) = acc[ai][bj][m][n] * rsv[ai * 4 + m]; }
        }
    }
};
struct EpiStoreE {
    static constexpr bool PERM = true, AFTER_DRAIN = false;
    bf16_t* C; int ldc; float* ssp;
    __device__ __forceinline__ void operator()(const f32x4 (&acc)[2][2][4][2], const Unit& u, int wr, int wc, int fr, int fq) const {
        const int row0 = u.pm * BM + wr * 64 + fr, col0 = u.pn * BM + wc * 32 + 8 * fq;
#pragma unroll
        for (int ai = 0; ai < 2; ++ai)
#pragma unroll
            for (int m = 0; m < 4; ++m) { const int row = row0 + ai * HALF + m * 16; bf16_t* rowp = C + (size_t)row * ldc + col0; float sq = 0.f;
#pragma unroll
                for (int bj = 0; bj < 2; ++bj) { const f32x4 v0 = acc[ai][bj][m][0], v1 = acc[ai][bj][m][1];
                    sq += (v0[0] * v0[0] + v0[1] * v0[1]) + (v0[2] * v0[2] + v0[3] * v0[3]) + (v1[0] * v1[0] + v1[1] * v1[1]) + (v1[2] * v1[2] + v1[3] * v1[3]);
                    u32x4 w; w.x = pack_bf16_sw(v0[0], v0[1]); w.y = pack_bf16_sw(v0[2], v0[3]); w.z = pack_bf16_sw(v1[0], v1[1]); w.w = pack_bf16_sw(v1[2], v1[3]);
                    *(u32x4*)(rowp + bj * HALF) = w; }
                sq += __shfl_xor(sq, 16); sq += __shfl_xor(sq, 32);
                if (fq == 0) ssp[(size_t)row * 32 + u.pn * 4 + wc] = sq; }
    }
};
struct EpiPle {
    static constexpr bool PERM = true, AFTER_DRAIN = false;
    const bf16_t* E; const float* rstdE; const float* wpost; const bf16_t* hin; int ldc; const float* rin; bf16_t* hout; float* ssp;
    __device__ __forceinline__ void operator()(const f32x4 (&acc)[2][2][4][2], const Unit& u, int wr, int wc, int fr, int fq) const {
        const int row0 = u.pm * BM + wr * 64 + fr, col0 = u.pn * BM + wc * 32 + 8 * fq;
#pragma unroll
        for (int g = 0; g < 8; ++g) { const int ai = g >> 2, m = g & 3, row = row0 + ai * HALF + m * 16; const size_t off = (size_t)row * ldc + col0;
            const float rs = rstdE[row], ri = rin[row];
            float sq = 0.f;
#pragma unroll
            for (int bj = 0; bj < 2; ++bj) { const u32x4 bv = *(const u32x4*)(hin + off + bj * HALF); const float bb[8] = {bflo(bv.x), bfhi(bv.x), bflo(bv.y), bfhi(bv.y), bflo(bv.z), bfhi(bv.z), bflo(bv.w), bfhi(bv.w)};
                const u32x4 ev = *(const u32x4*)(E + off + bj * HALF); const float eb[8] = {bflo(ev.x), bfhi(ev.x), bflo(ev.y), bfhi(ev.y), bflo(ev.z), bfhi(ev.z), bflo(ev.w), bfhi(ev.w)};
                float r[8];
#pragma unroll
                for (int n = 0; n < 2; ++n) { const f32x4 a = acc[ai][bj][m][n];
                    const f32x4 ww = *(const f32x4*)(wpost + col0 + bj * HALF + 4 * n);
#pragma unroll
                    for (int j = 0; j < 4; ++j) { r[4 * n + j] = bb[4 * n + j] + eb[4 * n + j] * rs * ww[j] * sigmoidf_(a[j] * ri); sq += r[4 * n + j] * r[4 * n + j]; } }
                u32x4 pk; pk.x = cvt_pk_bf16(r[0], r[1]); pk.y = cvt_pk_bf16(r[2], r[3]); pk.z = cvt_pk_bf16(r[4], r[5]); pk.w = cvt_pk_bf16(r[6], r[7]);
                *(u32x4*)(hout + off + bj * HALF) = pk; }
            sq += __shfl_xor(sq, 16); sq += __shfl_xor(sq, 32);
            if (fq == 0) ssp[(size_t)row * 32 + u.pn * 4 + wc] = sq;
            asm volatile("" ::: "memory"); }
    }
};
template <class Epi, class Sched, bool STAMP = false>
__device__ __forceinline__ void gemm_phase(PG8_LAS unsigned char* lds, const Gemm g, const Sched& S, const Epi& E, unsigned long long* stamps) {
    int tid = threadIdx.x; asm volatile("" : "+v"(tid)); const int wid = __builtin_amdgcn_readfirstlane(tid >> 6), lane = tid & 63, wr = wid >> 2, wc = wid & 3, fr = lane & 15, fq = lane >> 4;
    const int K = g.K, nt = K / BK;
    int ts_lo = 0, ts_hi = 0, nts = 0; const unsigned long long rt_entry = STAMP ? (unsigned long long)wall_clock64() : 0ull;
#define PG8_STAMP() do { if (STAMP && wid == 0 && nts < 64) { const unsigned long long _c = (unsigned long long)clock64(); \
        ts_lo = (lane == nts) ? (int)(unsigned)_c : ts_lo; ts_hi = (lane == nts) ? (int)(unsigned)(_c >> 32) : ts_hi; ++nts; } } while (0)
    PG8_STAMP();
    unsigned voffA[2], voffB[2];
#pragma unroll
    for (int i = 0; i < 2; ++i) { int R, C; stage_rc(tid * 16 + i * 8192, R, C); const int Rb = Epi::PERM ? ((R & ~31) + perm32(R & 31)) : R;
        voffA[i] = (unsigned)(R * K + C) * 2u; voffB[i] = (unsigned)(Rb * K + C) * 2u; }
    const size_t kstep = (size_t)(BK * 2);
    const size_t hstep = (size_t)HALF * K * 2;
    const size_t tstep = 2 * hstep;
    const unsigned ldsw = (unsigned)wid * 1024u;
    const int aoff = lds_byte(wr * 64 + fr, fq * 8), boff = lds_byte(wc * 32 + fr, fq * 8);
#define PG8_SA(b, h) (((b) * 2 + (h)) * HTB)
#define PG8_SB(b, h) ((4 + (b) * 2 + (h)) * HTB)
#define PG8_STAGE(bufoff, gbase, voff) do { _Pragma("unroll") for (int _i = 0; _i < 2; ++_i) \
        __builtin_amdgcn_global_load_lds((const unsigned*)((const char*)(gbase) + (voff)[_i]), (PG8_LAS unsigned*)(lds + (bufoff) + ldsw + _i * 8192), 16, 0, 0); } while (0)
#define PG8_LDA(dst, b, h) do { _Pragma("unroll") for (int m = 0; m < 4; ++m) _Pragma("unroll") for (int k = 0; k < 2; ++k) dst[m][k] = *(const PG8_LAS bf16x8*)(lds + PG8_SA(b, h) + aoff + m * 2048 + k * 1024); } while (0)
#define PG8_LDB(dst, b, h) do { _Pragma("unroll") for (int n = 0; n < 2; ++n) _Pragma("unroll") for (int k = 0; k < 2; ++k) dst[n][k] = *(const PG8_LAS bf16x8*)(lds + PG8_SB(b, h) + boff + n * 2048 + k * 1024); } while (0)
#define PG8_MMA(ai, bj, At, Bt) do { __builtin_amdgcn_s_setprio(1); _Pragma("unroll") for (int m = 0; m < 4; ++m) _Pragma("unroll") for (int n = 0; n < 2; ++n) _Pragma("unroll") for (int k = 0; k < 2; ++k) \
        acc[ai][bj][m][n] = __builtin_amdgcn_mfma_f32_16x16x32_bf16(Bt[n][k], At[m][k], acc[ai][bj][m][n], 0, 0, 0); __builtin_amdgcn_s_setprio(0); } while (0)
#define PG8_WAIT_V(n) asm volatile("s_waitcnt vmcnt(" #n ")" ::: "memory")
#define PG8_WAIT_L(n) asm volatile("s_waitcnt lgkmcnt(" #n ")" ::: "memory")
#define PG8_BAR __builtin_amdgcn_s_barrier()
#define PG8_SCHED __builtin_amdgcn_sched_barrier(0)
    Unit cur, nxt; int ui = 0;
    if (!S.next(0, cur)) return;
    f32x4 acc[2][2][4][2];
#pragma unroll
    for (int a = 0; a < 2; ++a)
#pragma unroll
        for (int b = 0; b < 2; ++b)
#pragma unroll
            for (int m = 0; m < 4; ++m)
#pragma unroll
                for (int n = 0; n < 2; ++n) acc[a][b][m][n] = (f32x4){0.f, 0.f, 0.f, 0.f};
    bf16x8 At[4][2], B0[2][2], B1[2][2];
    const char* cA = (const char*)g.A + (size_t)cur.pm * tstep; const char* cB = (const char*)g.Bt + (size_t)cur.pn * tstep;
    S.a_ready(cur);
    PG8_STAGE(PG8_SB(0, 0), cB, voffB); PG8_STAGE(PG8_SA(0, 0), cA, voffA); PG8_STAGE(PG8_SB(0, 1), cB + hstep, voffB); PG8_STAGE(PG8_SA(0, 1), cA + hstep, voffA);
    if (wr == 1) PG8_BAR;
    PG8_WAIT_V(4); PG8_BAR;
    PG8_STAGE(PG8_SB(1, 0), cB + kstep, voffB); PG8_STAGE(PG8_SA(1, 0), cA + kstep, voffA); PG8_STAGE(PG8_SB(1, 1), cB + hstep + kstep, voffB);
    PG8_WAIT_V(6); PG8_BAR;
    PG8_STAMP();
    for (;;) {
        const bool has_next = S.next(ui + 1, nxt);
        const char* nA = has_next ? (const char*)g.A + (size_t)nxt.pm * tstep : cA; const char* nB = has_next ? (const char*)g.Bt + (size_t)nxt.pn * tstep : cB;
        for (int t = 0; t < nt; t += 2) {
            const bool last = (t == nt - 2);
            const char* a1 = cA + (size_t)(t + 1) * kstep;
            const char* a2 = last ? nA : cA + (size_t)(t + 2) * kstep; const char* b2 = last ? nB : cB + (size_t)(t + 2) * kstep;
            const char* a3 = a2 + kstep; const char* b3 = b2 + kstep;
            if (last && has_next) S.a_ready(nxt);
            PG8_LDB(B0, 0, 0); PG8_SCHED; PG8_LDA(At, 0, 0); PG8_STAGE(PG8_SA(1, 1), a1 + hstep, voffA);
            PG8_WAIT_L(8); PG8_BAR; PG8_WAIT_L(0); PG8_MMA(0, 0, At, B0); PG8_BAR; PG8_SCHED;
            PG8_LDB(B1, 0, 1); PG8_STAGE(PG8_SB(0, 0), b2, voffB);
            PG8_BAR; PG8_WAIT_L(0); PG8_MMA(0, 1, At, B1); PG8_BAR;
            PG8_LDA(At, 0, 1); PG8_STAGE(PG8_SA(0, 0), a2, voffA);
            PG8_BAR; PG8_WAIT_L(0); PG8_MMA(1, 0, At, B0); PG8_BAR; PG8_SCHED;
            PG8_STAGE(PG8_SB(0, 1), b2 + hstep, voffB);
            PG8_WAIT_V(6); PG8_BAR; PG8_MMA(1, 1, At, B1); PG8_BAR;
            PG8_LDB(B0, 1, 0); PG8_SCHED; PG8_LDA(At, 1, 0); PG8_STAGE(PG8_SA(0, 1), a2 + hstep, voffA);
            PG8_WAIT_L(8); PG8_BAR; PG8_WAIT_L(0); PG8_MMA(0, 0, At, B0); PG8_BAR; PG8_SCHED;
            PG8_LDB(B1, 1, 1); PG8_STAGE(PG8_SB(1, 0), b3, voffB);
            PG8_BAR; PG8_WAIT_L(0); PG8_MMA(0, 1, At, B1); PG8_BAR;
            PG8_LDA(At, 1, 1); PG8_STAGE(PG8_SA(1, 0), a3, voffA);
            PG8_BAR; PG8_WAIT_L(0); PG8_MMA(1, 0, At, B0); PG8_BAR; PG8_SCHED;
            PG8_STAGE(PG8_SB(1, 1), b3 + hstep, voffB);
            PG8_WAIT_V(6); PG8_BAR; PG8_MMA(1, 1, At, B1); PG8_BAR;
        }
        PG8_STAMP();
        if constexpr (!Epi::AFTER_DRAIN) { E(acc, cur, wr, wc, fr, fq); S.done(cur); }
        PG8_STAMP();
        if (!has_next) break;
#pragma unroll
        for (int a = 0; a < 2; ++a)
#pragma unroll
            for (int b = 0; b < 2; ++b)
#pragma unroll
                for (int m = 0; m < 4; ++m)
#pragma unroll
                    for (int n = 0; n < 2; ++n) acc[a][b][m][n] = (f32x4){0.f, 0.f, 0.f, 0.f};
        cur = nxt; cA = nA; cB = nB; ++ui;
    }
    PG8_WAIT_V(0);
    if (wr == 0) PG8_BAR;
    PG8_BAR;
    if constexpr (Epi::AFTER_DRAIN) { E.fused(acc, cur, wr, wc, fr, fq, lds, wid, lane); S.done(cur); }
    PG8_STAMP();
    if (STAMP && wid == 0) { stamps[lane] = lane < nts ? (((unsigned long long)(unsigned)ts_hi << 32) | (unsigned)ts_lo) : 0ull;
        if (lane == 62) stamps[62] = rt_entry; if (lane == 63) stamps[63] = (unsigned long long)wall_clock64(); }
#undef PG8_STAMP
#undef PG8_SA
#undef PG8_SB
#undef PG8_STAGE
#undef PG8_LDA
#undef PG8_LDB
#undef PG8_MMA
#undef PG8_WAIT_V
#undef PG8_WAIT_L
#undef PG8_BAR
#undef PG8_SCHED
}
}
using namespace pg8;

constexpr int T = 8192, D = 2048, DFF = 5504, NFF = 2 * DFF;
constexpr int NAB = 13568, NAB_BF = 13312, NFOX = 6144, NFOX_BF = 6144;
constexpr int PZ = 0, PXBC = 2048, PQ = 5120, PF = 7168, PV_ = 9216, PG = 11264;
constexpr float EPS = 1e-6f;
constexpr int NTHR = 512;
constexpr int LDS_BYTES = 131072 + 64;
constexpr size_t OFF_H = 0, SZ_H = (size_t)T * D * 4;
constexpr size_t OFF_XN = OFF_H + SZ_H, SZ_XN = (size_t)T * D * 2;
constexpr size_t OFF_WB0 = OFF_XN + SZ_XN, SZ_WB0 = (size_t)NAB * D * 2;
constexpr size_t OFF_WB1 = OFF_WB0 + SZ_WB0, SZ_WB1 = (size_t)D * DFF * 2;
constexpr size_t OFF_WB2 = OFF_WB1 + SZ_WB1, SZ_WB2 = (size_t)D * 256 * 2;
constexpr size_t OFF_BIG = OFF_WB2 + SZ_WB2;
constexpr size_t OFF_ACT = OFF_BIG;
constexpr size_t OFF_PROJ = OFF_BIG, SZ_PROJ = (size_t)T * NAB_BF * 2;
constexpr size_t OFF_AUX = OFF_PROJ + SZ_PROJ, SZ_AUX = (size_t)T * 256 * 4;
constexpr size_t OFF_XC = OFF_AUX + SZ_AUX, SZ_XC = (size_t)T * 3072 * 2;
constexpr size_t OFF_STS = OFF_XC + SZ_XC, SZ_STS = (size_t)128 * 32 * 64 * 128 * 4;
constexpr size_t OFF_STH = OFF_STS + SZ_STS, SZ_STH = (size_t)128 * 16 * 128 * 128 * 4;
constexpr size_t OFF_Y = OFF_STH + SZ_STH, SZ_Y = (size_t)T * 4096 * 2;
constexpr size_t OFF_CDS = OFF_Y + SZ_Y, SZ_CDS = 128 * 32 * 4;
constexpr size_t OFF_CDH = OFF_CDS + SZ_CDS, SZ_CDH = 128 * 16 * 128 * 4;
constexpr size_t OFF_BAR = OFF_CDH + SZ_CDH;
constexpr size_t OFF_HB2 = OFF_BAR + 16384;
constexpr size_t OFF_RS = OFF_HB2 + SZ_XN, SZ_RS = (size_t)T * 4;
constexpr size_t OFF_SSP = OFF_RS + SZ_RS, SZ_SSP = (size_t)T * 32 * 4;
constexpr size_t OFF_SSPE = OFF_SSP + SZ_SSP;
constexpr size_t OFF_SSPB = OFF_SSPE + SZ_SSP;
constexpr size_t WS_END = OFF_SSPB + SZ_SSP;
constexpr size_t OFF_QKV = OFF_BIG, SZ_QKV = (size_t)T * NFOX_BF * 2;
constexpr size_t OFF_FAUX = OFF_QKV + SZ_QKV;
constexpr size_t OFF_DCUM = OFF_FAUX + SZ_AUX, SZ_DCUM = (size_t)256 * T * 4;
constexpr size_t OFF_O = OFF_DCUM + SZ_DCUM;
constexpr size_t OFF_VT = OFF_O + (size_t)T * D * 2;
constexpr size_t OFF_KNT = OFF_VT + (size_t)T * D * 2;
constexpr size_t OFF_PB = OFF_BIG + (size_t)96 * 1024 * 1024, SZ_PB = (size_t)T * 256 * 2;
constexpr size_t OFF_E = OFF_PB + SZ_PB, SZ_E = (size_t)T * D * 4;
constexpr size_t OFF_RSTD = OFF_E + SZ_E;

struct Params { const float* in[27]; float* out; unsigned char* ws; int ph_lo, ph_hi; };

__device__ __forceinline__ float wave_sum(float v) {
#pragma unroll
    for (int o = 32; o >= 1; o >>= 1) v += __shfl_xor(v, o);
    return v;
}
template <bool F32OUT>
__device__ __forceinline__ void rmsnorm_phase(const float* X, const float* w, bf16_t* ob, float* of) {
    int tq = threadIdx.x; asm volatile("" : "+v"(tq)); const int lane = tq & 63, gw = blockIdx.x * 8 + (tq >> 6), nw = gridDim.x * 8;
    for (int row = gw; row < T; row += nw) {
        const f32x4* xr = (const f32x4*)(X + (size_t)row * D);
        f32x4 v[8]; float ss = 0.f;
#pragma unroll
        for (int i = 0; i < 8; ++i) { v[i] = xr[lane + 64 * i]; ss += v[i][0] * v[i][0] + v[i][1] * v[i][1] + v[i][2] * v[i][2] + v[i][3] * v[i][3]; }
        ss = wave_sum(ss);
        const float rstd = rsqrtf(ss * (1.0f / D) + EPS);
#pragma unroll
        for (int i = 0; i < 8; ++i) { const f32x4 wv = ((const f32x4*)w)[lane + 64 * i]; const f32x4 y = v[i] * rstd * wv;
            if (F32OUT) ((f32x4*)(of + (size_t)row * D))[lane + 64 * i] = y;
            else { u32x2 p; p.x = cvt_pk_bf16(y[0], y[1]); p.y = cvt_pk_bf16(y[2], y[3]); ((u32x2*)(ob + (size_t)row * D))[lane + 64 * i] = p; } }
    }
}
__device__ __forceinline__ void finalnorm_phase(const bf16_t* hb, const float* w, float* out) {
    int tq = threadIdx.x; asm volatile("" : "+v"(tq)); const int lane = tq & 63, gw = blockIdx.x * 8 + (tq >> 6), nw = gridDim.x * 8;
    for (int row = gw; row < T; row += nw) {
        const u32x4* xr = (const u32x4*)(hb + (size_t)row * D); float v[32]; float sm = 0.f;
#pragma unroll
        for (int i = 0; i < 4; ++i) { const u32x4 q = xr[lane + 64 * i]; const unsigned qs[4] = {q.x, q.y, q.z, q.w};
#pragma unroll
            for (int e = 0; e < 4; ++e) { v[8 * i + 2 * e] = bflo(qs[e]); v[8 * i + 2 * e + 1] = bfhi(qs[e]); sm += v[8 * i + 2 * e] * v[8 * i + 2 * e] + v[8 * i + 2 * e + 1] * v[8 * i + 2 * e + 1]; } }
        sm = wave_sum(sm);
        const float rstd = rsqrtf(sm * (1.0f / D) + EPS);
#pragma unroll
        for (int i = 0; i < 4; ++i) { const int c0 = (lane + 64 * i) * 8; const f32x4 w0 = *(const f32x4*)(w + c0), w1 = *(const f32x4*)(w + c0 + 4);
            f32x4 y0, y1;
#pragma unroll
            for (int j = 0; j < 4; ++j) { y0[j] = v[8 * i + j] * rstd * w0[j]; y1[j] = v[8 * i + 4 + j] * rstd * w1[j]; }
            *(f32x4*)(out + (size_t)row * D + c0) = y0; *(f32x4*)(out + (size_t)row * D + c0 + 4) = y1; }
    }
}
__device__ __forceinline__ void prep_phase(const float* X, bf16_t* hb, float* rs0) {
    int tq = threadIdx.x; asm volatile("" : "+v"(tq)); const int lane = tq & 63, gw = blockIdx.x * 8 + (tq >> 6), nw = gridDim.x * 8;
    for (int row = gw; row < T; row += nw) {
        const f32x4* xr = (const f32x4*)(X + (size_t)row * D); float sm = 0.f;
#pragma unroll
        for (int i = 0; i < 8; ++i) { const f32x4 v = xr[lane + 64 * i]; sm += v[0] * v[0] + v[1] * v[1] + v[2] * v[2] + v[3] * v[3];
            u32x2 p; p.x = cvt_pk_bf16(v[0], v[1]); p.y = cvt_pk_bf16(v[2], v[3]); ((u32x2*)(hb + (size_t)row * D))[lane + 64 * i] = p; }
        sm = wave_sum(sm);
        if (lane == 0) rs0[row] = rsqrtf(sm * (1.0f / D) + EPS);
    }
}
__device__ __forceinline__ void rsfinal_phase(const float* ssp, float* rs) {
    int tq = threadIdx.x; asm volatile("" : "+v"(tq));
    for (int row = blockIdx.x * NTHR + tq; row < T; row += gridDim.x * NTHR) { const f32x4* p = (const f32x4*)(ssp + (size_t)row * 32); float sm = 0.f;
#pragma unroll
        for (int i = 0; i < 8; ++i) { const f32x4 v = p[i]; sm += (v[0] + v[1]) + (v[2] + v[3]); }
        rs[row] = rsqrtf(sm * (1.0f / D) + EPS); }
}
__device__ __forceinline__ void rowrstd_phase(const float* X, float* rs) {
    int tq = threadIdx.x; asm volatile("" : "+v"(tq)); const int lane = tq & 63, gw = blockIdx.x * 8 + (tq >> 6), nw = gridDim.x * 8;
    for (int row = gw; row < T; row += nw) {
        const f32x4* xr = (const f32x4*)(X + (size_t)row * D); float ss = 0.f;
#pragma unroll
        for (int i = 0; i < 8; ++i) { const f32x4 v = xr[lane + 64 * i]; ss += v[0] * v[0] + v[1] * v[1] + v[2] * v[2] + v[3] * v[3]; }
        ss = wave_sum(ss);
        if (lane == 0) rs[row] = rsqrtf(ss * (1.0f / D) + EPS);
    }
}
__device__ __forceinline__ int src_col(int mode, int n, int Nsrc) {
    if (mode == 1) { const int pn = n >> 8, r = n & 255; return (r >> 7) * DFF + pn * 128 + (r & 127); }
    if (mode == 2) { if (n < 5120) return n; if (n < 13312) return n + 32; if (n < 13344) return n - 13312 + 5120; return -1; }
    if (mode == 3) return n < 16 ? 6144 + n : -1;
    return n < Nsrc ? n : -1;
}
__device__ __forceinline__ void convert_w(const float* W, int K, int Nsrc, bf16_t* Bt, int Ndst, int mode, unsigned char* lds, const float* nw = nullptr, int wk = -1, int nwk = 0) {
    if (wk < 0) { wk = blockIdx.x; nwk = gridDim.x; }
    int t = threadIdx.x; asm volatile("" : "+v"(t));
    const int lane = t & 63, nkt = K >> 6, ntiles = (Ndst >> 6) * nkt;
    for (int tl = wk * 8 + (t >> 6); tl < ntiles; tl += nwk * 8) {
        const int nnt = Ndst >> 6; const int n0 = (tl % nnt) << 6, k0 = (tl / nnt) << 6;
        const int sc = src_col(mode, n0 + lane, Nsrc);
        const float* src = W + (size_t)k0 * Nsrc + (sc >= 0 ? sc : 0);
        float v[64];
#pragma unroll
        for (int k = 0; k < 64; ++k) v[k] = src[(size_t)k * Nsrc];
        if (nw) {
#pragma unroll
            for (int k = 0; k < 64; ++k) v[k] *= nw[k0 + k]; }
        bf16_t* dst = Bt + (size_t)(n0 + lane) * K + k0;
#pragma unroll
        for (int q = 0; q < 8; ++q) { u32x4 w4;
            w4.x = cvt_pk_bf16(v[8 * q], v[8 * q + 1]); w4.y = cvt_pk_bf16(v[8 * q + 2], v[8 * q + 3]); w4.z = cvt_pk_bf16(v[8 * q + 4], v[8 * q + 5]); w4.w = cvt_pk_bf16(v[8 * q + 6], v[8 * q + 7]);
            if (sc < 0) w4 = (u32x4){0u, 0u, 0u, 0u};
            *(u32x4*)(dst + 8 * q) = w4; }
    }
}
__device__ __forceinline__ void convert_flat(const float* src, bf16_t* dst, int n) {
    int tq = threadIdx.x; asm volatile("" : "+v"(tq)); const int gt = blockIdx.x * NTHR + tq, ng = gridDim.x * NTHR;
    for (int i = gt; i < n / 4; i += ng) { const f32x4 v = ((const f32x4*)src)[i]; u32x2 p; p.x = cvt_pk_bf16(v[0], v[1]); p.y = cvt_pk_bf16(v[2], v[3]); ((u32x2*)dst)[i] = p; }
}
__device__ __forceinline__ void conv_phase(const bf16_t* PROJ, const float* cw, const float* cb, bf16_t* XC) {
    int tq = threadIdx.x; asm volatile("" : "+v"(tq)); const int gt = blockIdx.x * NTHR + tq, nseg = (int)(gridDim.x * NTHR) / 384;
    if (gt < nseg * 384) {
        const int c8 = (gt % 384) * 8, sg = gt / 384, len = (T + nseg - 1) / nseg, t0 = sg * len, t1 = min(T, t0 + len);
        float wk[4][8], bb[8];
#pragma unroll
        for (int e = 0; e < 8; ++e) { bb[e] = cb[c8 + e];
#pragma unroll
            for (int k = 0; k < 4; ++k) wk[k][e] = cw[k * 3072 + c8 + e]; }
        u32x4 h0 = {0u, 0u, 0u, 0u}, h1 = h0, h2 = h0;
        if (t0 >= 3 && t0 < T) { h0 = *(const u32x4*)(PROJ + (size_t)(t0 - 3) * NAB_BF + PXBC + c8); h1 = *(const u32x4*)(PROJ + (size_t)(t0 - 2) * NAB_BF + PXBC + c8); h2 = *(const u32x4*)(PROJ + (size_t)(t0 - 1) * NAB_BF + PXBC + c8); }
        for (int t = t0; t < t1; ++t) {
            const u32x4 h3 = *(const u32x4*)(PROJ + (size_t)t * NAB_BF + PXBC + c8);
            const u32x4 hs[4] = {h0, h1, h2, h3};
            float a[8];
#pragma unroll
            for (int e = 0; e < 8; ++e) a[e] = bb[e];
#pragma unroll
            for (int k = 0; k < 4; ++k) { const u32x4 xv = hs[k];
                a[0] += bflo(xv.x) * wk[k][0]; a[1] += bfhi(xv.x) * wk[k][1]; a[2] += bflo(xv.y) * wk[k][2]; a[3] += bfhi(xv.y) * wk[k][3];
                a[4] += bflo(xv.z) * wk[k][4]; a[5] += bfhi(xv.z) * wk[k][5]; a[6] += bflo(xv.w) * wk[k][6]; a[7] += bfhi(xv.w) * wk[k][7]; }
            u32x4 w; w.x = cvt_pk_bf16(siluf_(a[0]), siluf_(a[1])); w.y = cvt_pk_bf16(siluf_(a[2]), siluf_(a[3])); w.z = cvt_pk_bf16(siluf_(a[4]), siluf_(a[5])); w.w = cvt_pk_bf16(siluf_(a[6]), siluf_(a[7]));
            *(u32x4*)(XC + (size_t)t * 3072 + c8) = w;
            h0 = h1; h1 = h2; h2 = h3;
        }
    }
}

__device__ __forceinline__ bf16x8 frag(const bf16_t* X, int ld, int row0, int k0, int lane) { return *(const bf16x8*)(X + (row0 + (lane & 15)) * ld + k0 + (lane >> 4) * 8); }
#define MMA_T(acc, Aop, Bop) acc = __builtin_amdgcn_mfma_f32_16x16x32_bf16(Bop, Aop, acc, 0, 0, 0)

__device__ __forceinline__ void ssd_dtcum(const float* AUX, const float* dt_bias, const float* a_log, int c, int h, float* dts, float* cums) {
    int tq = threadIdx.x; asm volatile("" : "+v"(tq)); if (tq < 64) { const int l = tq;
        const float dt = softplusf_(AUX[(size_t)(c * 64 + l) * 256 + h] + dt_bias[h]);
        float s = dt * (-__expf(a_log[h]));
#pragma unroll
        for (int o = 1; o < 64; o <<= 1) { const float u = __shfl_up(s, o); if (l >= o) s += u; }
        dts[l] = dt; cums[l] = s; }
}

__device__ __forceinline__ void ssd_states(const bf16_t* XC, const float* AUX, const float* dt_bias, const float* a_log, bf16_t* STS, float* CDS, unsigned char* lds) {
    bf16_t* XWt = (bf16_t*)lds;
    bf16_t* Bt = (bf16_t*)(lds + 9216);
    float* dts = (float*)(lds + 9216 + 18432);
    float* cums = dts + 64;
    int t = threadIdx.x; asm volatile("" : "+v"(t));
    const int lane = t & 63, w = t >> 6;
    float dtraw = 0.f; u32x4 xv, bv[2];
#define SS_LOAD(IT) do { const int c_ = (IT) >> 5, h_ = (IT) & 31; \
        if (t < 64) dtraw = AUX[(size_t)(c_ * 64 + t) * 256 + h_]; \
        xv = *(const u32x4*)(XC + (size_t)(c_ * 64 + (t >> 3)) * 3072 + h_ * 64 + (t & 7) * 8); \
        _Pragma("unroll") for (int i = 0; i < 2; ++i) bv[i] = *(const u32x4*)(XC + (size_t)(c_ * 64 + (t >> 4) + 32 * i) * 3072 + 2048 + (h_ >> 3) * 128 + (t & 15) * 8); } while (0)
    int it = blockIdx.x;
    if (it < 128 * 32) SS_LOAD(it);
    for (; it < 128 * 32; it += gridDim.x) {
        const int c = it >> 5, h = it & 31;
        if (t < 64) { const float dt = softplusf_(dtraw + dt_bias[h]); float sc = dt * (-__expf(a_log[h]));
#pragma unroll
            for (int o = 1; o < 64; o <<= 1) { const float u = __shfl_up(sc, o); if (t >= o) sc += u; }
            dts[t] = dt; cums[t] = sc; }
        __syncthreads();
        { const int l = t >> 3, p8 = (t & 7) * 8; const float sc = dts[l] * __expf(cums[63] - cums[l]);
          const unsigned xs[4] = {xv.x, xv.y, xv.z, xv.w};
#pragma unroll
          for (int e = 0; e < 4; ++e) { XWt[(p8 + 2 * e) * 72 + l] = f2bf(bflo(xs[e]) * sc); XWt[(p8 + 2 * e + 1) * 72 + l] = f2bf(bfhi(xs[e]) * sc); } }
#pragma unroll
        for (int i = 0; i < 2; ++i) { const int l = (t >> 4) + 32 * i, n8 = (t & 15) * 8;
          const unsigned bs[4] = {bv[i].x, bv[i].y, bv[i].z, bv[i].w};
#pragma unroll
          for (int e = 0; e < 4; ++e) { Bt[(n8 + 2 * e) * 72 + l] = (bf16_t)(bs[e] & 0xffffu); Bt[(n8 + 2 * e + 1) * 72 + l] = (bf16_t)(bs[e] >> 16); } }
        if (t == 0) CDS[c * 32 + h] = __expf(cums[63]);
        if (it + (int)gridDim.x < 128 * 32) SS_LOAD(it + (int)gridDim.x);
        __syncthreads();
        { const int p0 = (w & 3) * 16; const bf16x8 a0 = frag(XWt, 72, p0, 0, lane), a1 = frag(XWt, 72, p0, 32, lane);
#pragma unroll
          for (int i = 0; i < 4; ++i) { const int n0 = ((w >> 2) * 4 + i) * 16; f32x4 acc = {0.f, 0.f, 0.f, 0.f};
            MMA_T(acc, a0, frag(Bt, 72, n0, 0, lane)); MMA_T(acc, a1, frag(Bt, 72, n0, 32, lane));
            u32x2 pk; pk.x = pack_bf16_sw(acc[0], acc[1]); pk.y = pack_bf16_sw(acc[2], acc[3]);
            *(u32x2*)(STS + ((size_t)(c * 32 + h) * 64 + p0 + (lane & 15)) * 128 + n0 + 4 * (lane >> 4)) = pk; } }
        __syncthreads();
    }
#undef SS_LOAD
}
__device__ __forceinline__ float hgrn_lb(const float* lg, int j) {
    const float a = lg[j], b = lg[2048 + j], c = lg[4096 + j], m = fmaxf(a, fmaxf(b, c));
    const float ea = __expf(a - m), eb = __expf(b - m), ec = __expf(c - m); return ea / (ea + eb + ec);
}
__device__ __forceinline__ void hgrn_states(const bf16_t* PROJ, const float* lbl, bf16_t* STH, float* CDH, unsigned char* lds) {
    bf16_t* KEt = (bf16_t*)lds;
    bf16_t* Vt = (bf16_t*)(lds + 18432);
    float* part = (float*)(lds + 36864);
    int t = threadIdx.x; asm volatile("" : "+v"(t));
    const int lane = t & 63, w = t >> 6, k = t & 127, lq = t >> 7;
    bf16_t fr[16]; u32x4 vv[2];
#define HS_LOAD(IT) do { const int c_ = (IT) >> 4, h_ = (IT) & 15; \
        _Pragma("unroll") for (int i = 0; i < 16; ++i) fr[i] = PROJ[(size_t)(c_ * 64 + lq * 16 + i) * NAB_BF + PF + h_ * 128 + k]; \
        _Pragma("unroll") for (int i = 0; i < 2; ++i) vv[i] = *(const u32x4*)(PROJ + (size_t)(c_ * 64 + (t >> 4) + 32 * i) * NAB_BF + PV_ + h_ * 128 + (t & 15) * 8); } while (0)
    int it = blockIdx.x;
    if (it < 128 * 16) HS_LOAD(it);
    for (; it < 128 * 16; it += gridDim.x) {
        const int c = it >> 4, h = it & 15;
        const float lb = hgrn_lb(lbl, h * 128 + k);
        float lf[16], kk[16], sm = 0.f;
#pragma unroll
        for (int i = 0; i < 16; ++i) { const float f = lb + (1.0f - lb) * sigmoidf_(bf2f(fr[i])); kk[i] = 1.0f - f; lf[i] = __logf(f); sm += lf[i]; }
        part[lq * 128 + k] = sm;
#pragma unroll
        for (int i = 0; i < 2; ++i) { const int l = (t >> 4) + 32 * i, v8 = (t & 15) * 8;
          const unsigned vs[4] = {vv[i].x, vv[i].y, vv[i].z, vv[i].w};
#pragma unroll
          for (int e = 0; e < 4; ++e) { Vt[(v8 + 2 * e) * 72 + l] = (bf16_t)(vs[e] & 0xffffu); Vt[(v8 + 2 * e + 1) * 72 + l] = (bf16_t)(vs[e] >> 16); } }
        __syncthreads();
        { float off = 0.f, tot = 0.f;
#pragma unroll
          for (int j = 0; j < 4; ++j) { const float pj = part[j * 128 + k]; tot += pj; if (j < lq) off += pj; }
          float run = off;
#pragma unroll
          for (int i = 0; i < 16; ++i) { run += lf[i]; KEt[k * 72 + lq * 16 + i] = f2bf(kk[i] * __expf(tot - run)); }
          if (lq == 0) CDH[(size_t)(c * 16 + h) * 128 + k] = __expf(tot); }
        if (it + (int)gridDim.x < 128 * 16) HS_LOAD(it + (int)gridDim.x);
        __syncthreads();
        { const int v0 = w * 16; const bf16x8 a0 = frag(Vt, 72, v0, 0, lane), a1 = frag(Vt, 72, v0, 32, lane);
#pragma unroll
          for (int i = 0; i < 8; ++i) { const int k0 = i * 16; f32x4 acc = {0.f, 0.f, 0.f, 0.f};
            MMA_T(acc, a0, frag(KEt, 72, k0, 0, lane)); MMA_T(acc, a1, frag(KEt, 72, k0, 32, lane));
            u32x2 pk; pk.x = pack_bf16_sw(acc[0], acc[1]); pk.y = pack_bf16_sw(acc[2], acc[3]);
            *(u32x2*)(STH + ((size_t)(c * 16 + h) * 128 + v0 + (lane & 15)) * 128 + k0 + 4 * (lane >> 4)) = pk; } }
        __syncthreads();
    }
#undef HS_LOAD
}
__device__ __forceinline__ void scan_phase(bf16_t* STS, const float* CDS, bf16_t* STH, const float* CDH) {
    int tq = threadIdx.x; asm volatile("" : "+v"(tq)); const int gt = blockIdx.x * NTHR + tq, ng = gridDim.x * NTHR;
    for (int e2 = gt; e2 < 131072; e2 += ng) {
        const int e = e2 * 2;
        const int hs = e >> 13, hh = e >> 14, k = e & 127;
        f32x2 cs = {0.f, 0.f}, ch = {0.f, 0.f};
#pragma unroll 1
        for (int cb = 0; cb < 128; cb += 8) {
            unsigned sv[8], gv[8]; f32x2 dh[8]; float ds[8];
#pragma unroll
            for (int i = 0; i < 8; ++i) { const int c = cb + i; sv[i] = *(const unsigned*)(STS + (size_t)c * 262144 + e); gv[i] = *(const unsigned*)(STH + (size_t)c * 262144 + e);
                ds[i] = CDS[c * 32 + hs]; dh[i] = *(const f32x2*)(CDH + (size_t)(c * 16 + hh) * 128 + k); }
#pragma unroll
            for (int i = 0; i < 8; ++i) { const int c = cb + i; *(unsigned*)(STS + (size_t)c * 262144 + e) = cvt_pk_bf16(cs[0], cs[1]); *(unsigned*)(STH + (size_t)c * 262144 + e) = cvt_pk_bf16(ch[0], ch[1]);
                cs = cs * ds[i] + (f32x2){bflo(sv[i]), bfhi(sv[i])}; ch = ch * dh[i] + (f32x2){bflo(gv[i]), bfhi(gv[i])}; }
        }
    }
}
__device__ __forceinline__ void ssd_out(const bf16_t* XC, const bf16_t* PROJ, const float* AUX, const float* dt_bias, const float* a_log, const float* dskip, const float* normw,
                                        const bf16_t* STS, bf16_t* Y, unsigned char* lds) {
    bf16_t* Cs = (bf16_t*)lds;
    bf16_t* Bs = (bf16_t*)(lds + 17408);
    float* CB = (float*)(lds + 34816);
    bf16_t* Wm = (bf16_t*)(lds + 51456);
    bf16_t* XDt = (bf16_t*)(lds + 60672);
    bf16_t* PVs = (bf16_t*)(lds + 69888);
    float* dts8 = (float*)(lds + 87296);
    float* cums8 = dts8 + 512;
    float* ss = cums8 + 512;
    int t = threadIdx.x; asm volatile("" : "+v"(t));
    const int lane = t & 63, w = t >> 6, r = lane & 15, q4 = lane >> 4;
    const int l0 = (w & 3) * 16, lrow = l0 + r;
    u32x4 xv; u32x4 pv[2]; u32x2 xe[2], ze[2];
#define SO_LOAD(C_, H_) do { xv = *(const u32x4*)(XC + (size_t)((C_) * 64 + (t >> 3)) * 3072 + (H_) * 64 + (t & 7) * 8); \
        _Pragma("unroll") for (int i = 0; i < 2; ++i) pv[i] = *(const u32x4*)(STS + ((size_t)((C_) * 32 + (H_)) * 64 + (t >> 4) + 32 * i) * 128 + (t & 15) * 8); \
        _Pragma("unroll") for (int i = 0; i < 2; ++i) { const int pc_ = (H_) * 64 + ((w >> 2) * 2 + i) * 16 + 4 * q4; \
            xe[i] = *(const u32x2*)(XC + (size_t)((C_) * 64 + lrow) * 3072 + pc_); ze[i] = *(const u32x2*)(PROJ + (size_t)((C_) * 64 + lrow) * NAB_BF + PZ + pc_); } } while (0)
    for (int it = blockIdx.x; it < 128 * 4; it += gridDim.x) {
        const int c = it >> 2, g = it & 3;
#pragma unroll
        for (int i = 0; i < 2; ++i) { const int l = (t >> 4) + 32 * i, n8 = (t & 15) * 8; const bf16_t* src = XC + (size_t)(c * 64 + l) * 3072 + 2048 + g * 128 + n8;
            *(u32x4*)(Bs + l * 136 + n8) = *(const u32x4*)src; *(u32x4*)(Cs + l * 136 + n8) = *(const u32x4*)(src + 512); }
        { const int h = g * 8 + w; const float dt = softplusf_(AUX[(size_t)(c * 64 + lane) * 256 + h] + dt_bias[h]); float sc = dt * (-__expf(a_log[h]));
#pragma unroll
          for (int o = 1; o < 64; o <<= 1) { const float u = __shfl_up(sc, o); if (lane >= o) sc += u; }
          dts8[w * 64 + lane] = dt; cums8[w * 64 + lane] = sc; }
        if (t < 64) ss[t] = 0.f;
        SO_LOAD(c, g * 8);
        __syncthreads();
        {
#pragma unroll
          for (int i = 0; i < 2; ++i) { const int s0 = ((w >> 2) * 2 + i) * 16; f32x4 acc = {0.f, 0.f, 0.f, 0.f};
#pragma unroll
            for (int ks = 0; ks < 4; ++ks) MMA_T(acc, frag(Cs, 136, l0, ks * 32, lane), frag(Bs, 136, s0, ks * 32, lane));
#pragma unroll
            for (int j = 0; j < 4; ++j) CB[(l0 + r) * 65 + s0 + 4 * q4 + j] = acc[j]; } }
        __syncthreads();
#pragma unroll 1
        for (int hh = 0; hh < 8; ++hh) {
            const int h = g * 8 + hh; const float* dts = dts8 + hh * 64; const float* cums = cums8 + hh * 64;
            { const int l = t >> 3, s8 = (t & 7) * 8; const float cl = cums[l]; float wv[8];
#pragma unroll
              for (int e = 0; e < 8; ++e) { const int sx = s8 + e; wv[e] = (l >= sx) ? CB[l * 65 + sx] * __expf(cl - cums[sx]) : 0.f; }
              u32x4 pk; pk.x = cvt_pk_bf16(wv[0], wv[1]); pk.y = cvt_pk_bf16(wv[2], wv[3]); pk.z = cvt_pk_bf16(wv[4], wv[5]); pk.w = cvt_pk_bf16(wv[6], wv[7]);
              *(u32x4*)(Wm + l * 72 + s8) = pk; }
            { const int sx = t >> 3, p8 = (t & 7) * 8; const float sc = dts[sx];
              const unsigned xs[4] = {xv.x, xv.y, xv.z, xv.w};
#pragma unroll
              for (int e = 0; e < 4; ++e) { XDt[(p8 + 2 * e) * 72 + sx] = f2bf(bflo(xs[e]) * sc); XDt[(p8 + 2 * e + 1) * 72 + sx] = f2bf(bfhi(xs[e]) * sc); } }
#pragma unroll
            for (int i = 0; i < 2; ++i) *(u32x4*)(PVs + ((t >> 4) + 32 * i) * 136 + (t & 15) * 8) = pv[i];
            u32x2 xc[2], zc[2];
#pragma unroll
            for (int i = 0; i < 2; ++i) { xc[i] = xe[i]; zc[i] = ze[i]; }
            if (hh < 7) SO_LOAD(c, h + 1);
            __syncthreads();
            { const float el = __expf(cums[lrow]), dsk = dskip[h]; const size_t tok = (size_t)(c * 64 + lrow);
              const bf16x8 w0 = frag(Wm, 72, l0, 0, lane), w1 = frag(Wm, 72, l0, 32, lane);
              bf16x8 cf[4];
#pragma unroll
              for (int ks = 0; ks < 4; ++ks) cf[ks] = frag(Cs, 136, l0, ks * 32, lane);
#pragma unroll
              for (int i = 0; i < 2; ++i) { const int p0 = ((w >> 2) * 2 + i) * 16; f32x4 ad = {0.f, 0.f, 0.f, 0.f}, ao = {0.f, 0.f, 0.f, 0.f};
                MMA_T(ad, w0, frag(XDt, 72, p0, 0, lane)); MMA_T(ad, w1, frag(XDt, 72, p0, 32, lane));
#pragma unroll
                for (int ks = 0; ks < 4; ++ks) MMA_T(ao, cf[ks], frag(PVs, 136, p0, ks * 32, lane));
                const int pc = h * 64 + p0 + 4 * q4;
                const float xf[4] = {bflo(xc[i].x), bfhi(xc[i].x), bflo(xc[i].y), bfhi(xc[i].y)}, zf[4] = {bflo(zc[i].x), bfhi(zc[i].x), bflo(zc[i].y), bfhi(zc[i].y)};
                float y[4], sq = 0.f;
#pragma unroll
                for (int j = 0; j < 4; ++j) { y[j] = (ad[j] + el * ao[j] + dsk * xf[j]) * siluf_(zf[j]); sq += y[j] * y[j]; }
                sq += __shfl_xor(sq, 16); sq += __shfl_xor(sq, 32);
                if (q4 == 0) atomicAdd(&ss[lrow], sq);
                u32x2 pk; pk.x = cvt_pk_bf16(y[0], y[1]); pk.y = cvt_pk_bf16(y[2], y[3]); *(u32x2*)(Y + tok * 4096 + pc) = pk; } }
            __syncthreads();
        }
        { const float rstd = rsqrtf(ss[lrow] * (1.0f / 512.0f) + EPS); const size_t tok = (size_t)(c * 64 + lrow);
          u32x2 yv[16];
#pragma unroll
          for (int q = 0; q < 16; ++q) yv[q] = *(const u32x2*)(Y + tok * 4096 + (g * 8 + (q >> 1)) * 64 + ((w >> 2) * 2 + (q & 1)) * 16 + 4 * q4);
#pragma unroll
          for (int q = 0; q < 16; ++q) { const int pc = (g * 8 + (q >> 1)) * 64 + ((w >> 2) * 2 + (q & 1)) * 16 + 4 * q4; const f32x4 nw = *(const f32x4*)(normw + pc);
              u32x2 pk; pk.x = cvt_pk_bf16(bflo(yv[q].x) * rstd * nw[0], bfhi(yv[q].x) * rstd * nw[1]); pk.y = cvt_pk_bf16(bflo(yv[q].y) * rstd * nw[2], bfhi(yv[q].y) * rstd * nw[3]);
              *(u32x2*)(Y + tok * 4096 + pc) = pk; } }
        __syncthreads();
    }
#undef SO_LOAD
}
__device__ __forceinline__ void hgrn_out(const bf16_t* PROJ, const float* lbl, const float* normw, const bf16_t* STH, bf16_t* Y, unsigned char* lds) {
    bf16_t* QR = (bf16_t*)lds;
    bf16_t* KR = (bf16_t*)(lds + 17408);
    bf16_t* QD = (bf16_t*)(lds + 34816);
    bf16_t* ATT = (bf16_t*)(lds + 52224);
    bf16_t* Vt = (bf16_t*)(lds + 61440);
    bf16_t* PT = (bf16_t*)(lds + 79872);
    float* part = (float*)(lds + 114688);
    float* ss = part + 512;
    int t = threadIdx.x; asm volatile("" : "+v"(t));
    const int lane = t & 63, w = t >> 6, r = lane & 15, q4 = lane >> 4, k = t & 127, lq = t >> 7;
    const int l0 = (w & 3) * 16, lrow = l0 + r;
    bf16_t fr[16], qr[16]; u32x4 vv[2]; u32x4 pt[4]; u32x2 gv[4];
#define HO_LOAD(IT) do { const int c_ = (IT) >> 4, h_ = (IT) & 15; \
        _Pragma("unroll") for (int i = 0; i < 16; ++i) { const bf16_t* p_ = PROJ + (size_t)(c_ * 64 + lq * 16 + i) * NAB_BF + h_ * 128 + k; fr[i] = p_[PF]; qr[i] = p_[PQ]; } \
        _Pragma("unroll") for (int i = 0; i < 2; ++i) vv[i] = *(const u32x4*)(PROJ + (size_t)(c_ * 64 + (t >> 4) + 32 * i) * NAB_BF + PV_ + h_ * 128 + (t & 15) * 8); \
        _Pragma("unroll") for (int i = 0; i < 4; ++i) pt[i] = *(const u32x4*)(STH + ((size_t)(c_ * 16 + h_) * 128 + (t >> 4) + 32 * i) * 128 + (t & 15) * 8); \
        _Pragma("unroll") for (int i = 0; i < 4; ++i) gv[i] = *(const u32x2*)(PROJ + (size_t)(c_ * 64 + lrow) * NAB_BF + PG + h_ * 128 + ((w >> 2) * 4 + i) * 16 + 4 * q4); } while (0)
    int it = blockIdx.x;
    if (it < 128 * 16) HO_LOAD(it);
    for (; it < 128 * 16; it += gridDim.x) {
        const int c = it >> 4, h = it & 15;
        const float lb = hgrn_lb(lbl, h * 128 + k);
        float lf[16], kk[16], qs[16], sm = 0.f;
#pragma unroll
        for (int i = 0; i < 16; ++i) { const float f = lb + (1.0f - lb) * sigmoidf_(bf2f(fr[i])); kk[i] = 1.0f - f; lf[i] = __logf(f); sm += lf[i]; qs[i] = siluf_(bf2f(qr[i])); }
        part[lq * 128 + k] = sm;
        if (t < 64) ss[t] = 0.f;
#pragma unroll
        for (int i = 0; i < 2; ++i) { const int l = (t >> 4) + 32 * i, v8 = (t & 15) * 8;
          const unsigned vs[4] = {vv[i].x, vv[i].y, vv[i].z, vv[i].w};
#pragma unroll
          for (int e = 0; e < 4; ++e) { Vt[(v8 + 2 * e) * 72 + l] = (bf16_t)(vs[e] & 0xffffu); Vt[(v8 + 2 * e + 1) * 72 + l] = (bf16_t)(vs[e] >> 16); } }
#pragma unroll
        for (int i = 0; i < 4; ++i) *(u32x4*)(PT + ((t >> 4) + 32 * i) * 136 + (t & 15) * 8) = pt[i];
        u32x2 gc[4];
#pragma unroll
        for (int i = 0; i < 4; ++i) gc[i] = gv[i];
        __syncthreads();
        { float off = 0.f;
#pragma unroll
          for (int j = 0; j < 4; ++j) { const float pj = part[j * 128 + k]; if (j < lq) off += pj; }
          const float mid = part[k] + part[128 + k];
          float run = off;
#pragma unroll
          for (int i = 0; i < 16; ++i) { run += lf[i]; const int l = lq * 16 + i;
            QR[l * 136 + k] = f2bf(qs[i] * __expf(run - mid)); KR[l * 136 + k] = f2bf(kk[i] * __expf(mid - run)); QD[l * 136 + k] = f2bf(qs[i] * __expf(run)); } }
        if (it + (int)gridDim.x < 128 * 16) HO_LOAD(it + (int)gridDim.x);
        __syncthreads();
        {
#pragma unroll
          for (int i = 0; i < 2; ++i) { const int s0 = ((w >> 2) * 2 + i) * 16; f32x4 acc = {0.f, 0.f, 0.f, 0.f};
#pragma unroll
            for (int ks = 0; ks < 4; ++ks) MMA_T(acc, frag(QR, 136, l0, ks * 32, lane), frag(KR, 136, s0, ks * 32, lane));
            const int sb = s0 + 4 * q4;
            u32x2 pk; pk.x = cvt_pk_bf16(lrow >= sb ? acc[0] : 0.f, lrow >= sb + 1 ? acc[1] : 0.f); pk.y = cvt_pk_bf16(lrow >= sb + 2 ? acc[2] : 0.f, lrow >= sb + 3 ? acc[3] : 0.f);
            *(u32x2*)(ATT + lrow * 72 + sb) = pk; } }
        __syncthreads();
        { const size_t tok = (size_t)(c * 64 + lrow);
          const bf16x8 a0 = frag(ATT, 72, l0, 0, lane), a1 = frag(ATT, 72, l0, 32, lane);
          bf16x8 qd[4];
#pragma unroll
          for (int ks = 0; ks < 4; ++ks) qd[ks] = frag(QD, 136, l0, ks * 32, lane);
          f32x4 acc[4]; float sq = 0.f;
#pragma unroll
          for (int i = 0; i < 4; ++i) { const int v0 = ((w >> 2) * 4 + i) * 16; acc[i] = (f32x4){0.f, 0.f, 0.f, 0.f};
            MMA_T(acc[i], a0, frag(Vt, 72, v0, 0, lane)); MMA_T(acc[i], a1, frag(Vt, 72, v0, 32, lane));
#pragma unroll
            for (int ks = 0; ks < 4; ++ks) MMA_T(acc[i], qd[ks], frag(PT, 136, v0, ks * 32, lane));
            sq += acc[i][0] * acc[i][0] + acc[i][1] * acc[i][1] + acc[i][2] * acc[i][2] + acc[i][3] * acc[i][3]; }
          sq += __shfl_xor(sq, 16); sq += __shfl_xor(sq, 32);
          if (q4 == 0) atomicAdd(&ss[lrow], sq);
          __syncthreads();
          const float rstd = rsqrtf(ss[lrow] * (1.0f / 128.0f) + EPS);
#pragma unroll
          for (int i = 0; i < 4; ++i) { const int vc = h * 128 + ((w >> 2) * 4 + i) * 16 + 4 * q4;
            const f32x4 nw = *(const f32x4*)(normw + vc);
            u32x2 pk; pk.x = cvt_pk_bf16(acc[i][0] * rstd * nw[0] * siluf_(bflo(gc[i].x)), acc[i][1] * rstd * nw[1] * siluf_(bfhi(gc[i].x)));
            pk.y = cvt_pk_bf16(acc[i][2] * rstd * nw[2] * siluf_(bflo(gc[i].y)), acc[i][3] * rstd * nw[3] * siluf_(bfhi(gc[i].y)));
            *(u32x2*)(Y + tok * 4096 + 2048 + vc) = pk; } }
        __syncthreads();
    }
#undef HO_LOAD
}
__device__ __forceinline__ void fraw_phase(const bf16_t* XN, const bf16_t* WF, const float* RS, float* FT) {
    int t = threadIdx.x; asm volatile("" : "+v"(t));
    const int lane = t & 63, w = t >> 6, r = lane & 15, q4 = lane >> 4;
    for (int rt = blockIdx.x * 8 + w; rt < T / 16; rt += gridDim.x * 8) {
        const bf16_t* ap = XN + (size_t)(rt * 16 + r) * D + q4 * 8; const bf16_t* bp = WF + (size_t)r * D + q4 * 8;
        f32x4 acc = {0.f, 0.f, 0.f, 0.f};
#pragma unroll 8
        for (int ks = 0; ks < D / 32; ++ks) { const bf16x8 a = *(const bf16x8*)(ap + ks * 32), b = *(const bf16x8*)(bp + ks * 32); MMA_T(acc, a, b); }
        const float rs = RS[rt * 16 + r];
#pragma unroll
        for (int j = 0; j < 4; ++j) FT[(size_t)(4 * q4 + j) * T + rt * 16 + r] = acc[j] * rs;
    }
}
__device__ __forceinline__ void dcum_block(const float* FT, const float* b_f, int hd, float* out, unsigned char* lds) {
    float* part = (float*)lds;
    int t = threadIdx.x; asm volatile("" : "+v"(t));
    float v[16], sm = 0.f; const float bf = b_f[hd];
    const f32x4* src = (const f32x4*)(FT + (size_t)hd * T + t * 16);
#pragma unroll
    for (int q = 0; q < 4; ++q) { const f32x4 x4 = src[q];
#pragma unroll
      for (int j = 0; j < 4; ++j) { const float x = x4[j] + bf; sm += fminf(x, 0.f) - log1pf(__expf(-fabsf(x))); v[4 * q + j] = sm; } }
    float incl = sm;
#pragma unroll
    for (int o = 1; o < 64; o <<= 1) { const float u = __shfl_up(incl, o); if ((t & 63) >= o) incl += u; }
    __syncthreads();
    if ((t & 63) == 63) part[t >> 6] = incl;
    __syncthreads();
    float off = incl - sm;
    for (int j = 0; j < (t >> 6); ++j) off += part[j];
#pragma unroll
    for (int q = 0; q < 4; ++q) { f32x4 o = {off + v[4 * q], off + v[4 * q + 1], off + v[4 * q + 2], off + v[4 * q + 3]}; *(f32x4*)(out + t * 16 + 4 * q) = o; }
    asm volatile("s_waitcnt vmcnt(0)" ::: "memory");
    __syncthreads();
}
__device__ __forceinline__ void vtrans_phase(const bf16_t* QKV, bf16_t* VT, float* KNT, unsigned char* lds) {
    bf16_t* Vt = (bf16_t*)lds;
    float* wm = (float*)(lds + 18432);
    int t = threadIdx.x; asm volatile("" : "+v"(t));
    for (int it = blockIdx.x; it < 16 * 128; it += gridDim.x) {
        const int hd = it & 15, k0 = (it >> 4) * 64;
        { const int key = t >> 3, d16 = (t & 7) * 16; const bf16_t* vp = QKV + (size_t)(k0 + key) * NFOX_BF + 4096 + hd * 128 + d16;
          const u32x4 va = *(const u32x4*)vp, vb = *(const u32x4*)(vp + 8), ka = *(const u32x4*)(vp - 2048), kb = *(const u32x4*)(vp - 2048 + 8);
          const int kq = key & 31, slot = (key & 32) + ((kq >> 2) & 3) * 8 + (kq >> 4) * 4 + (kq & 3);
          const unsigned vs[8] = {va.x, va.y, va.z, va.w, vb.x, vb.y, vb.z, vb.w}, ks[8] = {ka.x, ka.y, ka.z, ka.w, kb.x, kb.y, kb.z, kb.w};
          float sq = 0.f;
#pragma unroll
          for (int e = 0; e < 8; ++e) { Vt[(d16 + 2 * e) * 72 + slot] = (bf16_t)(vs[e] & 0xffffu); Vt[(d16 + 2 * e + 1) * 72 + slot] = (bf16_t)(vs[e] >> 16);
            const float a = bflo(ks[e]), b = bfhi(ks[e]); sq += a * a + b * b; }
          sq += __shfl_xor(sq, 1); sq += __shfl_xor(sq, 2); sq += __shfl_xor(sq, 4);
          sq = fmaxf(sq, __shfl_xor(sq, 8)); sq = fmaxf(sq, __shfl_xor(sq, 16)); sq = fmaxf(sq, __shfl_xor(sq, 32));
          if ((t & 63) == 0) wm[t >> 6] = sq; }
        __syncthreads();
#pragma unroll
        for (int i = 0; i < 2; ++i) { const int idx = t + 512 * i, d = idx >> 3, pc = (idx & 7) * 8;
          *(u32x4*)(VT + ((size_t)hd * 128 + d) * T + k0 + pc) = *(const u32x4*)(Vt + d * 72 + pc); }
        if (t == 0) { float mx = wm[0];
#pragma unroll
          for (int i = 1; i < 8; ++i) mx = fmaxf(mx, wm[i]);
          KNT[hd * 128 + (it >> 4)] = sqrtf(mx); }
        __syncthreads();
    }
}
__device__ __forceinline__ void fox_attn(const bf16_t* QKV, const bf16_t* VT, const float* FT, const float* b_f, float* DCP, const float* KNT, bf16_t* O, unsigned char* lds) {
    float* const DCUM = DCP + (size_t)blockIdx.x * T;
    int cur_hd = -1;
    bf16_t* Ks = (bf16_t*)lds;
    bf16_t* Vt = (bf16_t*)(lds + 34816);
    float* DK = (float*)(lds + 71680);
    unsigned* VOTE = (unsigned*)(lds + 72192);
    int t = threadIdx.x; asm volatile("" : "+v"(t));
    const int lane = t & 63, w = t >> 6, r = lane & 15, q4 = lane >> 4;
    const float LOG2E = 1.44269504088896f, SC2 = 0.08838834764831845f * LOG2E;
    for (int it = blockIdx.x; it < 512; it += gridDim.x) {
        const int rnd = it >> 8, b = it & 255, jj = b >> 4, hd = b & 15;
        const int qb = rnd == 0 ? 31 - jj : jj;
        const int q0 = qb * 256, rbase = q0 + w * 32;
        if (hd != cur_hd) { dcum_block(FT, b_f, hd, DCUM, lds); cur_hd = hd; }
        const int nkt = 4 * qb + 4;
        float kn = fmaxf(lane < nkt ? KNT[hd * 128 + lane] : 0.f, lane + 64 < nkt ? KNT[hd * 128 + 64 + lane] : 0.f);
#pragma unroll
        for (int o = 32; o >= 1; o >>= 1) kn = fmaxf(kn, __shfl_xor(kn, o));
        bf16x8 qf[2][4]; float dq[2], m[2], lsum[2], qnk[2]; f32x4 oacc[2][8];
#pragma unroll
        for (int g = 0; g < 2; ++g) { const int row = rbase + g * 16 + r; float sq = 0.f;
#pragma unroll
          for (int ks = 0; ks < 4; ++ks) { qf[g][ks] = *(const bf16x8*)(QKV + (size_t)row * NFOX_BF + hd * 128 + ks * 32 + q4 * 8);
#pragma unroll
            for (int e = 0; e < 8; ++e) { const float x = bf2f((bf16_t)qf[g][ks][e]); sq += x * x; } }
          sq += __shfl_xor(sq, 16); sq += __shfl_xor(sq, 32);
          qnk[g] = sqrtf(sq) * kn * SC2 * 1.001f + 1.0f;
          dq[g] = DCUM[row] * LOG2E; m[g] = -INFINITY; lsum[g] = 0.f;
#pragma unroll
          for (int i = 0; i < 8; ++i) oacc[g][i] = (f32x4){0.f, 0.f, 0.f, 0.f}; }
        const bf16_t* kptr = QKV + (size_t)(t >> 3) * NFOX_BF + 2048 + hd * 128 + (t & 7) * 16;
        const bf16_t* vptr = VT + ((size_t)hd * 128 + (t >> 2)) * T + (t & 3) * 16;
        const float* dptr = DCUM + (t & 63);
        const int kso = (t >> 3) * 136 + (t & 7) * 16, vso = (t >> 2) * 72 + (t & 3) * 16;
        u32x4 pk0, pk1, pv0, pv1; float pd;
        __syncthreads();
        { const int kl = (nkt - 1) * 64, cb = (nkt - 1) & 1; const bf16_t* kp = kptr + (size_t)kl * NFOX_BF; const bf16_t* vp = vptr + kl;
          pk0 = *(const u32x4*)kp; pk1 = *(const u32x4*)(kp + 8); pv0 = *(const u32x4*)vp; pv1 = *(const u32x4*)(vp + 8); pd = dptr[kl];
          *(u32x4*)(Ks + cb * 8704 + kso) = pk0; *(u32x4*)(Ks + cb * 8704 + kso + 8) = pk1; *(u32x4*)(Vt + cb * 9216 + vso) = pv0; *(u32x4*)(Vt + cb * 9216 + vso + 8) = pv1; if (t < 64) DK[cb * 64 + t] = pd * LOG2E; }
        __syncthreads();
        bool dead = false;
#pragma unroll 1
        for (int kt = nkt - 1; kt >= 0; --kt) {
            const int k0 = kt * 64, cur = kt & 1;
            const bool more = (kt > 0);
            float dnl = 0.f;
            if (more) { const bf16_t* kp = kptr + (size_t)(k0 - 64) * NFOX_BF; const bf16_t* vp = vptr + k0 - 64;
              pk0 = *(const u32x4*)kp; pk1 = *(const u32x4*)(kp + 8); pv0 = *(const u32x4*)vp; pv1 = *(const u32x4*)(vp + 8); pd = dptr[k0 - 64];
              dnl = DCUM[k0 - 1] * LOG2E; }
            if (k0 <= rbase + 31 && !dead) {
              const bf16_t* Kc = Ks + cur * 8704; const bf16_t* Vc = Vt + cur * 9216; const float* Dc = DK + cur * 64;
              f32x4 sc[2][4];
#pragma unroll
              for (int nt = 0; nt < 4; ++nt) { sc[0][nt] = (f32x4){0.f, 0.f, 0.f, 0.f}; sc[1][nt] = (f32x4){0.f, 0.f, 0.f, 0.f};
#pragma unroll
                for (int ks = 0; ks < 4; ++ks) { const bf16x8 kf = frag(Kc, 136, nt * 16, ks * 32, lane);
                  sc[0][nt] = __builtin_amdgcn_mfma_f32_16x16x32_bf16(kf, qf[0][ks], sc[0][nt], 0, 0, 0);
                  sc[1][nt] = __builtin_amdgcn_mfma_f32_16x16x32_bf16(kf, qf[1][ks], sc[1][nt], 0, 0, 0); } }
              f32x4 dk[4];
#pragma unroll
              for (int nt = 0; nt < 4; ++nt) dk[nt] = *(const f32x4*)(Dc + nt * 16 + 4 * q4);
              bf16x8 pf[2][2];
#pragma unroll
              for (int g = 0; g < 2; ++g) {
                const int row = rbase + g * 16 + r; const bool diag = (k0 + 63 > rbase + g * 16);
                float mx = -INFINITY;
#pragma unroll
                for (int nt = 0; nt < 4; ++nt)
#pragma unroll
                  for (int j = 0; j < 4; ++j) { float v = sc[g][nt][j] * SC2 + (dq[g] - dk[nt][j]); if (diag && (k0 + nt * 16 + 4 * q4 + j > row)) v = -INFINITY; sc[g][nt][j] = v; mx = fmaxf(mx, v); }
                mx = fmaxf(mx, __shfl_xor(mx, 16)); mx = fmaxf(mx, __shfl_xor(mx, 32));
                const float mn = fmaxf(m[g], mx), alpha = __builtin_amdgcn_exp2f(m[g] - mn); m[g] = mn;
                float ps = 0.f;
#pragma unroll
                for (int nt = 0; nt < 4; ++nt)
#pragma unroll
                  for (int j = 0; j < 4; ++j) { const float p = __builtin_amdgcn_exp2f(sc[g][nt][j] - mn); sc[g][nt][j] = p; ps += p; }
                lsum[g] = lsum[g] * alpha + ps;
#pragma unroll
                for (int i = 0; i < 8; ++i) oacc[g][i] *= alpha;
#pragma unroll
                for (int k2 = 0; k2 < 2; ++k2) { union { bf16x8 v; unsigned u[4]; } pp;
                  pp.u[0] = cvt_pk_bf16(sc[g][2 * k2][0], sc[g][2 * k2][1]); pp.u[1] = cvt_pk_bf16(sc[g][2 * k2][2], sc[g][2 * k2][3]);
                  pp.u[2] = cvt_pk_bf16(sc[g][2 * k2 + 1][0], sc[g][2 * k2 + 1][1]); pp.u[3] = cvt_pk_bf16(sc[g][2 * k2 + 1][2], sc[g][2 * k2 + 1][3]);
                  pf[g][k2] = pp.v; }
              }
#pragma unroll
              for (int k2 = 0; k2 < 2; ++k2)
#pragma unroll
                for (int i = 0; i < 8; ++i) { const bf16x8 vf = frag(Vc, 72, i * 16, k2 * 32, lane);
                  oacc[0][i] = __builtin_amdgcn_mfma_f32_16x16x32_bf16(vf, pf[0][k2], oacc[0][i], 0, 0, 0);
                  oacc[1][i] = __builtin_amdgcn_mfma_f32_16x16x32_bf16(vf, pf[1][k2], oacc[1][i], 0, 0, 0); }
            }
            if (more) { const int nb = cur ^ 1;
              const float ub = fmaxf(qnk[0] + (dq[0] - dnl) - m[0], qnk[1] + (dq[1] - dnl) - m[1]);
              dead = dead || (__ballot(!(ub < -160.0f)) == 0ull);
              *(u32x4*)(Ks + nb * 8704 + kso) = pk0; *(u32x4*)(Ks + nb * 8704 + kso + 8) = pk1; *(u32x4*)(Vt + nb * 9216 + vso) = pv0; *(u32x4*)(Vt + nb * 9216 + vso + 8) = pv1;
              if (t < 64) DK[nb * 64 + t] = pd * LOG2E;
              if (lane == 0) VOTE[cur * 8 + w] = dead ? 1u : 0u; }
            __syncthreads();
            if (more) { const u32x4 va = *(const u32x4*)(VOTE + cur * 8), vb = *(const u32x4*)(VOTE + cur * 8 + 4);
              if ((va.x & va.y & va.z & va.w & vb.x & vb.y & vb.z & vb.w) != 0u) break; }
        }
#pragma unroll
        for (int g = 0; g < 2; ++g) { const int row = rbase + g * 16 + r;
          float ls = lsum[g]; ls += __shfl_xor(ls, 16); ls += __shfl_xor(ls, 32);
          const float inv = 1.0f / ls;
#pragma unroll
          for (int i = 0; i < 8; ++i) { u32x2 pk; pk.x = cvt_pk_bf16(oacc[g][i][0] * inv, oacc[g][i][1] * inv); pk.y = cvt_pk_bf16(oacc[g][i][2] * inv, oacc[g][i][3] * inv);
            *(u32x2*)(O + (size_t)row * D + hd * 128 + i * 16 + 4 * q4) = pk; } }
    }
}

#define XB_TMO      128
#define XB_XCNT(j)  (256  + 64 * (j))
#define XB_XSUB(j)  (1280 + 64 * (j))
#define XB_XGEN(j)  (2304 + 64 * (j))
#define XB_TOP      3328
#define XB_TOPGEN   3392
#define XCD_BAR_WORDS 3456
#define XB_SPIN_CAP (1u << 20)
__device__ __forceinline__ unsigned xb_ld(unsigned* p)              { return __hip_atomic_load(p, __ATOMIC_RELAXED, __HIP_MEMORY_SCOPE_AGENT); }
__device__ __forceinline__ unsigned xb_add(unsigned* p, unsigned v) { return __hip_atomic_fetch_add(p, v, __ATOMIC_RELAXED, __HIP_MEMORY_SCOPE_AGENT); }
__device__ __forceinline__ unsigned xb_xcc_id() { return (unsigned)__builtin_amdgcn_s_getreg((3 << 11) | 20) & 0xFu; }
#define XB_SPIN(cond, bar) do { unsigned _sp = 0; while (cond) { __builtin_amdgcn_s_sleep(1); \
    if ((++_sp & 255u) == 0u) { if (xb_ld(&(bar)[XB_TMO])) break; if (_sp > XB_SPIN_CAP) { atomicAdd(&(bar)[XB_TMO], 1u); break; } } } } while (0)
struct XcdBarrier { unsigned* bar; unsigned x; volatile PG8_LAS unsigned* st; };
__device__ __forceinline__ XcdBarrier xcd_barrier_post(unsigned* bar, volatile PG8_LAS unsigned* st) {
    XcdBarrier b; b.bar = bar; b.x = xb_xcc_id(); b.st = st;
    if (threadIdx.x == 0) (void)xb_add(&bar[XB_XCNT(b.x)], 1u);
    return b;
}
__device__ __forceinline__ void xcd_barrier_complete(unsigned* bar, unsigned x, unsigned& nloc, unsigned& nx) {
    const unsigned G = gridDim.x * gridDim.y * gridDim.z;
    unsigned sum, cnt, mine, sp = 0u;
    for (;;) {
        sum = 0u; cnt = 0u; mine = 0u;
#pragma unroll
        for (unsigned j = 0; j < 16; ++j) { const unsigned c = xb_ld(&bar[XB_XCNT(j)]); sum += c; cnt += (c > 0u) ? 1u : 0u; mine = (j == x) ? c : mine; }
        if (sum == G) break;
        __builtin_amdgcn_s_sleep(1);
        if ((++sp & 255u) == 0u) { if (xb_ld(&bar[XB_TMO])) break; if (sp > XB_SPIN_CAP) { atomicAdd(&bar[XB_TMO], 1u); break; } }
    }
    nloc = mine > 0u ? mine : 1u; nx = cnt > 0u ? cnt : 1u;
}
__device__ __forceinline__ void xcd_barrier(const XcdBarrier& b) {
    asm volatile("s_waitcnt vmcnt(0)" ::: "memory");
    __syncthreads();
    if (threadIdx.x == 0) {
        unsigned* bar = b.bar;
        __builtin_amdgcn_s_waitcnt(0);
        unsigned nloc = b.st[0], nx = b.st[1];
        if (nloc == 0u) { xcd_barrier_complete(bar, b.x, nloc, nx); b.st[0] = nloc; b.st[1] = nx; }
        const unsigned old = xb_add(&bar[XB_XSUB(b.x)], 1u);
        const unsigned gen = old / nloc;
        if (old + 1u == (gen + 1u) * nloc) {
            __builtin_amdgcn_fence(__ATOMIC_RELEASE, "agent");
            asm volatile("s_waitcnt vmcnt(0)" ::: "memory");
            const unsigned og = xb_add(&bar[XB_TOP], 1u);
            const unsigned tg = og / nx;
            if (og + 1u == (tg + 1u) * nx) xb_add(&bar[XB_TOPGEN], 1u);
            else XB_SPIN(xb_ld(&bar[XB_TOPGEN]) == tg, bar);
            __builtin_amdgcn_fence(__ATOMIC_ACQUIRE, "agent");
            xb_add(&bar[XB_XGEN(b.x)], 1u);
            asm volatile("s_waitcnt vmcnt(0)" ::: "memory");
        } else {
            XB_SPIN(xb_ld(&bar[XB_XGEN(b.x)]) == gen, bar);
            __builtin_amdgcn_fence(__ATOMIC_ACQUIRE, "agent");
            asm volatile("s_waitcnt vmcnt(0)" ::: "memory");
        }
    }
    __syncthreads();
}

template <class Epi>
__device__ __forceinline__ void run_gemm(unsigned char* lds, const bf16_t* A, const bf16_t* Bt, int N, int K, const Epi& E) {
    int Mv = T, Nv = N, Kv = K; asm volatile("" : "+s"(Mv), "+s"(Nv), "+s"(Kv)); Gemm g{A, Bt, Mv, Nv, Kv}; StaticOrder S; S.init(Mv, Nv, (int)gridDim.x, (int)blockIdx.x);
    gemm_phase<Epi, StaticOrder, false>((PG8_LAS unsigned char*)lds, g, S, E, nullptr);
}
__device__ __forceinline__ bool tail_worker(int nunits, int& wk, int& nwk) {
    const int G = gridDim.x, extra = nunits % G, c = blockIdx.x;
    if (extra == 0) { wk = c; nwk = G; return true; }
    if (c >= extra) { wk = c - extra; nwk = G - extra; return true; }
    return false;
}
__device__ __forceinline__ void rs_prestep(const float* ssp, float* rs, int N) {
    StaticOrder S; S.init(T, N, (int)gridDim.x, (int)blockIdx.x);
    int tq = threadIdx.x; asm volatile("" : "+v"(tq));
    unsigned donemask = 0u; Unit u;
    for (int i = 0; S.next(i, u); ++i) {
        if (donemask & (1u << u.pm)) continue;
        donemask |= (1u << u.pm);
        if (tq < 256) { const int row = u.pm * 256 + tq; const f32x4* p = (const f32x4*)(ssp + (size_t)row * 32); float sm = 0.f;
#pragma unroll
            for (int q = 0; q < 8; ++q) { const f32x4 v = p[q]; sm += (v[0] + v[1]) + (v[2] + v[3]); }
            rs[row] = rsqrtf(sm * (1.0f / D) + EPS); }
    }
    asm volatile("s_waitcnt vmcnt(0)" ::: "memory");
    __syncthreads();
}
constexpr int NPHASES = 22;
__global__ void __launch_bounds__(NTHR) mega(Params P) {
    extern __shared__ __attribute__((aligned(16))) unsigned char lds[];
    cg::grid_group grid = cg::this_grid();
    unsigned char* ws = P.ws;
    float* H = (float*)(ws + OFF_H); bf16_t* XN = (bf16_t*)(ws + OFF_XN); bf16_t* WB0 = (bf16_t*)(ws + OFF_WB0); bf16_t* WB1 = (bf16_t*)(ws + OFF_WB1); bf16_t* WB2 = (bf16_t*)(ws + OFF_WB2); bf16_t* HB2 = (bf16_t*)(ws + OFF_HB2); float* RS = (float*)(ws + OFF_RS); float* SSP = (float*)(ws + OFF_SSP); float* SSPE = (float*)(ws + OFF_SSPE); float* SSPB = (float*)(ws + OFF_SSPB); bf16_t* WBX = (bf16_t*)(ws + OFF_H);
    bf16_t* ACT = (bf16_t*)(ws + OFF_ACT);
    bf16_t* PROJ = (bf16_t*)(ws + OFF_PROJ); float* AUX = (float*)(ws + OFF_AUX); bf16_t* XC = (bf16_t*)(ws + OFF_XC);
    bf16_t* STS = (bf16_t*)(ws + OFF_STS); bf16_t* STH = (bf16_t*)(ws + OFF_STH); bf16_t* Y = (bf16_t*)(ws + OFF_Y); float* CDS = (float*)(ws + OFF_CDS); float* CDH = (float*)(ws + OFF_CDH);
    bf16_t* QKV = (bf16_t*)(ws + OFF_QKV); float* FAUX = (float*)(ws + OFF_FAUX); float* DCUM = (float*)(ws + OFF_DCUM); bf16_t* OB = (bf16_t*)(ws + OFF_O); bf16_t* VTB = (bf16_t*)(ws + OFF_VT); float* KNT = (float*)(ws + OFF_KNT);
    bf16_t* PB = (bf16_t*)(ws + OFF_PB); bf16_t* EB = (bf16_t*)(ws + OFF_E); float* RSTD = (float*)(ws + OFF_RSTD);
    volatile PG8_LAS unsigned* bst = (volatile PG8_LAS unsigned*)((PG8_LAS unsigned char*)lds + 131072);
    if (threadIdx.x < 4) bst[threadIdx.x] = 0u;
    __syncthreads();
    XcdBarrier xbar = xcd_barrier_post((unsigned*)(ws + OFF_BAR), bst);
    int ph = 0;
#define PHASE_BEGIN if (ph >= P.ph_lo && ph < P.ph_hi) { if (ph > P.ph_lo) { if (P.ph_hi < 0) grid.sync(); else xcd_barrier(xbar); }
#define PHASE_END } ++ph;
    PHASE_BEGIN
        prep_phase(P.in[0], HB2, RS);
        convert_w(P.in[3], D, NFF, WB0, NFF, 1, lds, P.in[2]);
    PHASE_END
#pragma unroll 1
    for (int L = 0; L < 2; ++L) {
#pragma unroll 1
        for (int f = 0; f < 2; ++f) {
            if (f == 1) {
                if (L == 0) {
                    PHASE_BEGIN { rs_prestep(SSP, RS, NAB); EpiProj E{PROJ, NAB_BF, NAB_BF / 256, AUX, RS}; run_gemm(lds, XN, WB0, NAB, D, E); int wk, nwk; if (tail_worker(32 * (NAB / 256), wk, nwk)) convert_w(P.in[15], 4096, D, WB1, D, 0, lds, nullptr, wk, nwk); } PHASE_END
                    PHASE_BEGIN conv_phase(PROJ, P.in[7], P.in[8], XC); PHASE_END
                    PHASE_BEGIN ssd_states(XC, AUX, P.in[9], P.in[10], STS, CDS, lds); hgrn_states(PROJ, P.in[13], STH, CDH, lds); PHASE_END
                    PHASE_BEGIN scan_phase(STS, CDS, STH, CDH); PHASE_END
                    PHASE_BEGIN ssd_out(XC, PROJ, AUX, P.in[9], P.in[10], P.in[11], P.in[12], STS, Y, lds); hgrn_out(PROJ, P.in[13], P.in[14], STH, Y, lds); PHASE_END
                } else {
                    PHASE_BEGIN { rs_prestep(SSP, RS, NFOX); EpiProj E{QKV, NFOX_BF, NFOX_BF / 256, FAUX, RS}; run_gemm(lds, XN, WB0, NFOX, D, E); int wk, nwk; if (tail_worker(32 * (NFOX / 256), wk, nwk)) convert_w(P.in[18], D, D, WB1, D, 0, lds, nullptr, wk, nwk); } PHASE_END
                    PHASE_BEGIN fraw_phase(XN, WB2, RS, FAUX); vtrans_phase(QKV, VTB, KNT, lds); PHASE_END
                    PHASE_BEGIN fox_attn(QKV, VTB, FAUX, P.in[17], DCUM, KNT, OB, lds); PHASE_END
                }
                PHASE_BEGIN
                    if (L == 0) { EpiResid E{XN, XN, D, 1.0f, SSP}; run_gemm(lds, Y, WB1, D, 4096, E); }
                    else { EpiResid E{XN, XN, D, 1.0f, SSP}; run_gemm(lds, OB, WB1, D, D, E); }
                    __syncthreads();
                    convert_w(P.in[20] + (size_t)L * D * NFF, D, NFF, WB0, NFF, 1, lds, P.in[19] + L * D);
                    convert_w(P.in[24] + (size_t)L * 256 * D, 256, D, WB2, D, 0, lds); convert_flat(P.in[1] + (size_t)L * T * 256, PB, T * 256);
                PHASE_END
            }
            const int bi = f == 0 ? 2 : 19;
            PHASE_BEGIN { if (f == 1 || L == 1) rs_prestep(f == 0 ? SSPB : SSP, RS, NFF);
                EpiSwiGLU E{ACT, DFF, RS}; run_gemm(lds, f == 0 ? HB2 : XN, (f == 0 && L == 1) ? WBX : WB0, NFF, D, E);
                int wk, nwk; if (tail_worker(32 * (NFF / 256), wk, nwk)) convert_w(P.in[bi + 2] + (size_t)L * DFF * D, DFF, D, WB1, D, 0, lds, nullptr, wk, nwk); } PHASE_END
            PHASE_BEGIN { EpiResid E{f == 0 ? HB2 : XN, XN, D, 0.5f, SSP}; run_gemm(lds, ACT, WB1, D, DFF, E); }
                __syncthreads();
                if (f == 0) {
                    if (L == 0) convert_w(P.in[6], D, 13344, WB0, NAB, 2, lds, P.in[5]);
                    else { convert_w(P.in[16], D, 6160, WB0, NFOX, 0, lds, P.in[5] + D); convert_w(P.in[16], D, 6160, WB2, 64, 3, lds, P.in[5] + D); }
                } else {
                    EpiStoreE E2{EB, D, SSPE}; run_gemm(lds, PB, WB2, D, 256, E2);
                    __syncthreads();
                    convert_w(P.in[23] + (size_t)L * D * D, D, D, WB0, D, 0, lds, P.in[22] + L * D);
                }
            PHASE_END
        }
        PHASE_BEGIN { rs_prestep(SSP, RS, D); rs_prestep(SSPE, RSTD, D);
            EpiPle E{EB, RSTD, P.in[25] + L * D, XN, D, RS, HB2, SSPB}; run_gemm(lds, XN, WB0, D, D, E); }
            if (L == 0) { __syncthreads(); convert_w(P.in[3] + (size_t)D * NFF, D, NFF, WBX, NFF, 1, lds, P.in[2] + D); }
        PHASE_END
    }
    PHASE_BEGIN finalnorm_phase(HB2, P.in[26], P.out); PHASE_END
}

extern "C" void kernel_launch(void* const* d_in, const int* in_sizes, int n_in, void* d_out, int out_size, void* d_ws, size_t ws_size, hipStream_t stream) {
    static int grid = 0;
    if (grid == 0) {
        if (n_in != 27 || ws_size < WS_END) { fprintf(stderr, "kernel_launch: need 27 inputs and %zu bytes of workspace (got %d, %zu)\n", (size_t)WS_END, n_in, ws_size); grid = -1; return; }
        int dev = 0, cus = 0, per_cu = 0;
        (void)hipGetDevice(&dev); (void)hipDeviceGetAttribute(&cus, hipDeviceAttributeMultiprocessorCount, dev);
        if (hipFuncSetAttribute((const void*)mega, hipFuncAttributeMaxDynamicSharedMemorySize, LDS_BYTES) != hipSuccess) { fprintf(stderr, "kernel_launch: hipFuncSetAttribute failed\n"); grid = -1; return; }
        if (hipOccupancyMaxActiveBlocksPerMultiprocessor(&per_cu, (const void*)mega, NTHR, LDS_BYTES) != hipSuccess || per_cu < 1) { fprintf(stderr, "kernel_launch: occupancy query says %d\n", per_cu); per_cu = 1; }
        (void)hipGetLastError();
        grid = cus * 1;
    }
    if (grid < 0) return;
    if (hipMemsetAsync((char*)d_ws + OFF_BAR, 0, 16384, stream) != hipSuccess) { fprintf(stderr, "kernel_launch: memset failed\n"); return; }
    Params p{};
    for (int i = 0; i < 27; ++i) p.in[i] = (const float*)d_in[i];
    p.out = (float*)d_out; p.ws = (unsigned char*)d_ws;
#if ONE_LAUNCH
    p.ph_lo = 0; p.ph_hi = NPHASES;
    void* args[] = {&p};
    hipError_t e = hipLaunchCooperativeKernel((const void*)mega, dim3(grid), dim3(NTHR), args, LDS_BYTES, stream);
    if (e != hipSuccess) fprintf(stderr, "cooperative launch failed: %s (grid %d)\n", hipGetErrorString(e), grid);
#else
    for (int ph = 0; ph < NPHASES; ++ph) { p.ph_lo = ph; p.ph_hi = ph + 1; hipLaunchKernelGGL(mega, dim3(grid), dim3(NTHR), LDS_BYTES, stream, p); }
#endif
}
```
